# Optimizing an MI355X kernel written in HIP

```python
import math
import jax
import jax.numpy as jnp
from jax import lax
import numpy as np

D_MODEL = 1024
BATCH = 4
SEQ = 8192
DEPTH = 4

GRID_W = 64
CTX_LEN = 256
N_MIXERS = 2
N_HEADS = 8
HEAD_DIM = 64
V_HEAD_DIM = 2 * HEAD_DIM
Q_BLOCK = 128
ROPE_BASE = 10000.0
ROPE_AXIS_DIM = HEAD_DIM // 2
D_RNN = D_MODEL
N_LRU_BLOCKS = 8
LRU_BLOCK = D_RNN // N_LRU_BLOCKS
CONV_W = 4
CONV_PAD_L = CONV_W // 2
CONV_PAD_R = CONV_W - 1 - CONV_PAD_L
RG_C = 8.0
D_FF = 2816
N_EXPERTS = 8
TOP_K = 2
D_FF_EXPERT = 3584
EPS = 1e-6
N_EVEN = (DEPTH + 1) // 2
N_ODD = DEPTH // 2

kernel_name = 'hybrid_diffattn_rglru_moe_dit'


def rmsnorm(x, g):
    xf = x.astype(jnp.float32)
    xf = xf * lax.rsqrt(jnp.mean(xf * xf, axis=-1, keepdims=True) + EPS)
    return xf.astype(x.dtype) * g


def modulate(x, g, shift, scale):
    return rmsnorm(x, g) * (1.0 + scale) + shift


def axial_rope_tables(n_tokens):
    rows = n_tokens // GRID_W
    row = jnp.repeat(jnp.arange(rows, dtype=jnp.float32), GRID_W)
    col = jnp.tile(jnp.arange(GRID_W, dtype=jnp.float32), rows)
    inv_freq = 1.0 / (ROPE_BASE ** (jnp.arange(0, ROPE_AXIS_DIM, 2, dtype=jnp.float32) / ROPE_AXIS_DIM))
    ang = jnp.stack([row[:, None] * inv_freq, col[:, None] * inv_freq], axis=1)
    ang = jnp.broadcast_to(ang[:, :, None, :], (n_tokens, 2, 2, ROPE_AXIS_DIM // 2))
    ang = ang.reshape(n_tokens, HEAD_DIM)
    return jnp.cos(ang), jnp.sin(ang)


def apply_axial_rope(x, cos, sin):
    xs = x.reshape(*x.shape[:-1], 2, 2, ROPE_AXIS_DIM // 2)
    rot = jnp.stack([-xs[..., 1, :], xs[..., 0, :]], axis=-2).reshape(x.shape)
    cos = cos[None, :, None, None, :].astype(x.dtype)
    sin = sin[None, :, None, None, :].astype(x.dtype)
    return x * cos + rot * sin


def diff_softmax_mix(q, k, v, lam):
    s = jnp.einsum('bqhpd,bkhpd->pbhqk', q, k).astype(jnp.float32)
    p = jax.nn.softmax(s, axis=-1)
    w = (p[0] - lam * p[1]).astype(v.dtype)
    return jnp.einsum('bhqk,bkhe->bqhe', w, v)


def diff_attention(h_lat, h_ctx, w_qkv, w_o, lam_vec, subln_g, lambda_init, cos, sin, with_ctx_out):
    bsz, n_lat, _ = h_lat.shape
    n_ctx = h_ctx.shape[1]
    scale = HEAD_DIM ** -0.5
    q_l, k_l, v_l = jnp.split(h_lat @ w_qkv, 3, axis=-1)
    q_l = apply_axial_rope(q_l.reshape(bsz, n_lat, N_HEADS, 2, HEAD_DIM) * scale, cos, sin)
    k_l = apply_axial_rope(k_l.reshape(bsz, n_lat, N_HEADS, 2, HEAD_DIM), cos, sin)
    v_l = v_l.reshape(bsz, n_lat, N_HEADS, V_HEAD_DIM)
    k_c, v_c = jnp.split(h_ctx @ w_qkv[:, D_MODEL:], 2, axis=-1)
    k_c = k_c.reshape(bsz, n_ctx, N_HEADS, 2, HEAD_DIM)
    v_c = v_c.reshape(bsz, n_ctx, N_HEADS, V_HEAD_DIM)
    lv = lam_vec.astype(jnp.float32)
    lam = jnp.exp(jnp.sum(lv[0] * lv[1])) - jnp.exp(jnp.sum(lv[2] * lv[3])) + lambda_init
    k_all = jnp.concatenate([k_l, k_c], axis=1)
    v_all = jnp.concatenate([v_l, v_c], axis=1)
    n_blocks = n_lat // Q_BLOCK
    q_blocks = q_l.reshape(bsz, n_blocks, Q_BLOCK, N_HEADS, 2, HEAD_DIM).swapaxes(0, 1)
    o_l = lax.map(lambda qb: diff_softmax_mix(qb, k_all, v_all, lam), q_blocks)
    o_l = o_l.swapaxes(0, 1).reshape(bsz, n_lat, N_HEADS, V_HEAD_DIM)

    def head_out(o):
        o = rmsnorm(o, subln_g) * (1.0 - lambda_init)
        return o.reshape(bsz, o.shape[1], D_MODEL) @ w_o

    y_l = head_out(o_l)
    if with_ctx_out:
        q_c = (h_ctx @ w_qkv[:, :D_MODEL]).reshape(bsz, n_ctx, N_HEADS, 2, HEAD_DIM) * scale
        y_c = head_out(diff_softmax_mix(q_c, k_c, v_c, lam))
    else:
        y_c = None
    return y_l, y_c


def depthwise_conv(u, w, b):
    y = lax.conv_general_dilated(u, w[:, None, :], window_strides=(1,),
                                 padding=[(CONV_PAD_L, CONV_PAD_R)],
                                 dimension_numbers=('NWC', 'WIO', 'NWC'),
                                 feature_group_count=u.shape[-1])
    return y + b


def rglru_coeffs(u, w_gates, b_gates, a_param):
    bsz, n, _ = u.shape
    ub = u.reshape(bsz, n, N_LRU_BLOCKS, LRU_BLOCK)
    g = jnp.einsum('bnkc,gkcd->gbnkd', ub, w_gates).reshape(2, bsz, n, D_RNN) + b_gates[:, None, None, :]
    g = jax.nn.sigmoid(g.astype(jnp.float32))
    r_t, i_t = g[0], g[1]
    log_a = RG_C * r_t * jax.nn.log_sigmoid(a_param.astype(jnp.float32))
    a_t = jnp.exp(log_a)
    b_t = jnp.sqrt(-jnp.expm1(2.0 * log_a)) * (i_t * u.astype(jnp.float32))
    return a_t, b_t


def linear_scan(a, b, h0, reverse):
    def combine(e1, e2):
        a1, b1 = e1
        a2, b2 = e2
        return a1 * a2, a2 * b1 + b2
    a_cum, b_cum = lax.associative_scan(combine, (a, b), reverse=reverse, axis=1)
    return a_cum * h0[:, None, :] + b_cum


def rglru_mixer(h_lat, h_ctx, w_in, conv_w, conv_b, gate_w, gate_b, a_param, w_out, with_ctx_out):
    bsz = h_lat.shape[0]
    proj_l = h_lat @ w_in
    proj_c = h_ctx @ w_in
    gate_l = jax.nn.gelu(proj_l[..., :D_RNN])
    u_l = depthwise_conv(proj_l[..., D_RNN:], conv_w, conv_b)
    u_c = depthwise_conv(proj_c[..., D_RNN:], conv_w, conv_b)
    h0 = jnp.zeros((bsz, D_RNN), jnp.float32)
    lat_states, ctx_states = [], []
    for d, reverse in enumerate((False, True)):
        a_c, b_c = rglru_coeffs(u_c, gate_w[d], gate_b[d], a_param[d])
        h_c = linear_scan(a_c, b_c, h0, reverse)
        h_c_final = h_c[:, 0] if reverse else h_c[:, -1]
        a_l, b_l = rglru_coeffs(u_l, gate_w[d], gate_b[d], a_param[d])
        lat_states.append(linear_scan(a_l, b_l, h_c_final, reverse))
        ctx_states.append(h_c)
    y_l = ((lat_states[0] + lat_states[1]).astype(gate_l.dtype) * gate_l) @ w_out
    if with_ctx_out:
        gate_c = jax.nn.gelu(proj_c[..., :D_RNN])
        y_c = ((ctx_states[0] + ctx_states[1]).astype(gate_c.dtype) * gate_c) @ w_out
    else:
        y_c = None
    return y_l, y_c


def swiglu(h, w_gate_up, w_down):
    gate, up = jnp.split(h @ w_gate_up, 2, axis=-1)
    return (jax.nn.silu(gate) * up) @ w_down


def moe_swiglu(h, router_w, w_gate_up, w_down):
    logits = (h @ router_w).astype(jnp.float32)
    top_val, top_idx = lax.top_k(logits, TOP_K)
    top_w = jax.nn.softmax(top_val, axis=-1)
    gates = jnp.einsum('bnk,bnke->bne', top_w,
                       jax.nn.one_hot(top_idx, N_EXPERTS, dtype=jnp.float32)).astype(h.dtype)
    y = jnp.zeros_like(h)
    for e in range(N_EXPERTS):
        y = y + gates[..., e:e + 1] * swiglu(h, w_gate_up[e], w_down[e])
    return y


def setup_inputs(seed: int = 0) -> dict:
    key = jax.random.key(seed)
    ks = jax.random.split(key, 25)
    f32 = jnp.float32

    def nrm(k, shape, scale):
        return jax.random.normal(k, shape, f32) * scale

    D = D_MODEL
    a0 = jax.random.uniform(ks[17], (N_ODD, 2, D_RNN), f32, 0.9, 0.999)
    s = a0 ** (1.0 / RG_C)
    return {
        'x': nrm(ks[0], (BATCH, SEQ, D), 1.0),
        'c': nrm(ks[1], (BATCH, D), 1.0),
        'ctx': nrm(ks[2], (BATCH, CTX_LEN, D), 1.0),
        'c_ctx': nrm(ks[3], (D,), 1.0),
        'mod_w': nrm(ks[4], (DEPTH, D, 6 * D), 0.5 * D ** -0.5),
        'mod_b': nrm(ks[5], (DEPTH, 6 * D), 0.02),
        'norm_mix_g': 1.0 + nrm(ks[6], (DEPTH, D), 0.02),
        'norm_ffn_g': 1.0 + nrm(ks[7], (DEPTH, D), 0.02),
        'attn_w_qkv': nrm(ks[8], (N_EVEN, D, 3 * D), D ** -0.5),
        'attn_w_o': nrm(ks[9], (N_EVEN, D, D), D ** -0.5),
        'attn_lambda': nrm(ks[10], (N_EVEN, 4, HEAD_DIM), 0.1),
        'attn_subln_g': 1.0 + nrm(ks[11], (N_EVEN, V_HEAD_DIM), 0.02),
        'lru_w_in': nrm(ks[12], (N_ODD, D, 2 * D_RNN), D ** -0.5),
        'lru_conv_w': nrm(ks[13], (N_ODD, CONV_W, D_RNN), CONV_W ** -0.5),
        'lru_conv_b': nrm(ks[14], (N_ODD, D_RNN), 0.01),
        'lru_gate_w': nrm(ks[15], (N_ODD, 2, 2, N_LRU_BLOCKS, LRU_BLOCK, LRU_BLOCK), LRU_BLOCK ** -0.5),
        'lru_gate_b': nrm(ks[16], (N_ODD, 2, 2, D_RNN), 0.01),
        'lru_a_param': jnp.log(s) - jnp.log1p(-s),
        'lru_w_out': nrm(ks[18], (N_ODD, D_RNN, D), D_RNN ** -0.5),
        'ffn_w_gate_up': nrm(ks[19], (N_EVEN, D, 2 * D_FF), D ** -0.5),
        'ffn_w_down': nrm(ks[20], (N_EVEN, D_FF, D), D_FF ** -0.5),
        'moe_router_w': nrm(ks[21], (N_ODD, D, N_EXPERTS), D ** -0.5),
        'moe_w_gate_up': nrm(ks[22], (N_ODD, N_EXPERTS, D, 2 * D_FF_EXPERT), D ** -0.5),
        'moe_w_down': nrm(ks[23], (N_ODD, N_EXPERTS, D_FF_EXPERT, D), D_FF_EXPERT ** -0.5),
        'final_norm_g': 1.0 + nrm(ks[24], (D,), 0.02),
    }


def reference(x, c, ctx, c_ctx, mod_w, mod_b, norm_mix_g, norm_ffn_g, attn_w_qkv, attn_w_o,
              attn_lambda, attn_subln_g, lru_w_in, lru_conv_w, lru_conv_b, lru_gate_w, lru_gate_b,
              lru_a_param, lru_w_out, ffn_w_gate_up, ffn_w_down, moe_router_w, moe_w_gate_up,
              moe_w_down, final_norm_g):
    n_lat = x.shape[1]
    cos, sin = axial_rope_tables(n_lat)
    silu_c = jax.nn.silu(c)
    silu_cc = jax.nn.silu(c_ctx)

    def channel_mixer(i, j, f):
        if i % 2 == 0:
            return swiglu(f, ffn_w_gate_up[j], ffn_w_down[j])
        return moe_swiglu(f, moe_router_w[j], moe_w_gate_up[j], moe_w_down[j])

    for i in range(DEPTH):
        last = i == DEPTH - 1
        j = i // N_MIXERS
        mod_l = (silu_c @ mod_w[i] + mod_b[i])[:, None, :]
        mod_c = silu_cc @ mod_w[i] + mod_b[i]
        sh1, sc1, g1, sh2, sc2, g2 = jnp.split(mod_l, 6, axis=-1)
        sh1c, sc1c, g1c, sh2c, sc2c, g2c = jnp.split(mod_c, 6, axis=-1)
        h_l = modulate(x, norm_mix_g[i], sh1, sc1)
        h_c = modulate(ctx, norm_mix_g[i], sh1c, sc1c)
        if i % N_MIXERS == 0:
            lambda_init = 0.8 - 0.6 * math.exp(-0.3 * i)
            y_l, y_c = diff_attention(h_l, h_c, attn_w_qkv[j], attn_w_o[j], attn_lambda[j],
                                      attn_subln_g[j], lambda_init, cos, sin, not last)
        else:
            y_l, y_c = rglru_mixer(h_l, h_c, lru_w_in[j], lru_conv_w[j], lru_conv_b[j], lru_gate_w[j],
                                   lru_gate_b[j], lru_a_param[j], lru_w_out[j], not last)
        x = x + g1 * y_l
        f_l = modulate(x, norm_ffn_g[i], sh2, sc2)
        x = x + g2 * channel_mixer(i, j, f_l)
        if not last:
            ctx = ctx + g1c * y_c
            f_c = modulate(ctx, norm_ffn_g[i], sh2c, sc2c)
            ctx = ctx + g2c * channel_mixer(i, j, f_c)
    return rmsnorm(x, final_norm_g)
```

```cpp
#define PROBE_MODE 0
#include <hip/hip_runtime.h>
#include <cstdio>
#include <cstdint>

#define LAS __attribute__((address_space(3)))
#define GAS __attribute__((address_space(1)))
typedef unsigned short bf16_t;
typedef short bf16x8 __attribute__((ext_vector_type(8)));
typedef short s16x4 __attribute__((ext_vector_type(4)));
typedef float f32x2 __attribute__((ext_vector_type(2)));
typedef float f32x4 __attribute__((ext_vector_type(4)));
typedef float f32x16 __attribute__((ext_vector_type(16)));
typedef unsigned u32x2 __attribute__((ext_vector_type(2)));
typedef unsigned u32x4 __attribute__((ext_vector_type(4)));
typedef int i32x2 __attribute__((ext_vector_type(2)));

#ifndef PROBE_MODE
#define PROBE_MODE 0
#endif
#ifndef MK_SPLIT
#define MK_SPLIT 0
#endif

constexpr int DM = 1024, NBATCH = 4, SEQ = 8192, CTXL = 256, DEPTH = 4;
constexpr int RL = NBATCH * SEQ, RC = NBATCH * CTXL, RT = RL + RC;
constexpr int NH = 8;
constexpr int FF = 2816, FE = 3584, NE = 8;
constexpr int MP_MAX = 2 * RT + NE * 256;
constexpr float EPS = 1e-6f;
constexpr float QSCALE = 0.125f * 1.4426950408889634f;
constexpr int NPHASE = 36;

constexpr size_t MiB = 1u << 20;
constexpr size_t WS_CTL = 0, CTL_ZERO_BYTES = 256 * 1024;
constexpr size_t WS_MOD = 1 * MiB;
constexpr size_t WS_ROPE = WS_MOD + 512 * 1024;
constexpr size_t WS_CNT = WS_ROPE + 64 * 1024;
constexpr size_t WS_SEG = WS_CNT + 64 * 1024;
constexpr size_t WS_TOKI = 2 * MiB;
constexpr size_t WS_TOKW = WS_TOKI + 512 * 1024;
constexpr size_t WS_TOKE = WS_TOKW + 512 * 1024;
constexpr size_t WS_PROBE = 3 * MiB + 768 * 1024;
constexpr size_t WS_TOT = 4 * MiB;
constexpr size_t WS_PRE = 9 * MiB;
constexpr size_t WS_WQKV = 12 * MiB;
constexpr size_t WS_WO = WS_WQKV + 12 * MiB;
constexpr size_t WS_WGU = WS_WO + 4 * MiB;
constexpr size_t WS_WDN = WS_WGU + 22 * MiB;
constexpr size_t WS_WIN = WS_WDN + 11 * MiB;
constexpr size_t WS_WOUT = WS_WIN + 8 * MiB;
constexpr size_t WS_GW = WS_WOUT + 4 * MiB;
constexpr size_t WS_MGU = WS_GW + 2 * MiB;
constexpr size_t WS_MDN = WS_MGU + 224 * MiB;
constexpr size_t WS_XS = WS_MDN + 112 * MiB;
constexpr size_t WS_H = WS_XS + 132 * MiB;
constexpr size_t WS_S = WS_H + 66 * MiB;
constexpr size_t WS_Q = WS_S, WS_K = WS_S + 66 * MiB, WS_V = WS_S + 132 * MiB, WS_O = WS_S + 198 * MiB, WS_ACT = WS_S + 264 * MiB;
constexpr size_t WS_STASH = WS_S + 446 * MiB;
constexpr size_t WS_GATE = WS_S, WS_P = WS_S + 66 * MiB, WS_HF = WS_S + 132 * MiB, WS_Z = WS_S + 264 * MiB;
constexpr size_t WS_ACTP = WS_S, WS_FP = WS_S + 476 * MiB, WS_YP = WS_S + 476 * MiB;
constexpr size_t WS_END = WS_S + 612 * MiB;
static_assert((size_t)RT * FF * 2 <= 182 * MiB && (size_t)MP_MAX * FE * 2 <= 476 * MiB && (size_t)MP_MAX * DM * 2 <= 136 * MiB, "scratch map");
constexpr int CW_TMO = 0, CW_CODE = 1, CW_BAR = 4096;

constexpr int RING_BYTES = 131072;
constexpr int MISC_OFF = RING_BYTES + 320;
constexpr int LDS_BYTES = 147456;

#define LDS_WAIT() asm volatile("s_waitcnt lgkmcnt(0)" ::: "memory")
#define VM_WAIT() asm volatile("s_waitcnt vmcnt(0)" ::: "memory")
__device__ __forceinline__ unsigned cvt_pk_bf16(float lo, float hi) { unsigned r; asm volatile("v_cvt_pk_bf16_f32 %0, %1, %2" : "=v"(r) : "v"(lo), "v"(hi)); return r; }
__device__ __forceinline__ float bf_lo(unsigned w) { return __uint_as_float(w << 16); }
__device__ __forceinline__ float bf_hi(unsigned w) { return __uint_as_float(w & 0xffff0000u); }
__device__ __forceinline__ float bf2f(bf16_t b) { return __uint_as_float(((unsigned)b) << 16); }
__device__ __forceinline__ float fast_exp2(float x) { return __builtin_amdgcn_exp2f(x); }
__device__ __forceinline__ float fast_rcp(float x) { return __builtin_amdgcn_rcpf(x); }
__device__ __forceinline__ float sigmoid_f(float x) { return fast_rcp(1.f + fast_exp2(-1.4426950408889634f * x)); }
template <int K> __device__ __forceinline__ float xor_swz(float v) { return __int_as_float(__builtin_amdgcn_ds_swizzle(__float_as_int(v), (K << 10) | 0x1F)); }
template <int K> __device__ __forceinline__ int xor_swz_i(int v) { return __builtin_amdgcn_ds_swizzle(v, (K << 10) | 0x1F); }
__device__ __forceinline__ float wave_sum(float v) {
    v += xor_swz<1>(v); v += xor_swz<2>(v); v += xor_swz<4>(v); v += xor_swz<8>(v); v += xor_swz<16>(v);
    const auto rr = __builtin_amdgcn_permlane32_swap(__float_as_uint(v), __float_as_uint(v), false, false);
    return __uint_as_float(rr[0]) + __uint_as_float(rr[1]);
}
__device__ __forceinline__ int wave_sum_i(int v) {
    v += xor_swz_i<1>(v); v += xor_swz_i<2>(v); v += xor_swz_i<4>(v); v += xor_swz_i<8>(v); v += xor_swz_i<16>(v);
    const auto rr = __builtin_amdgcn_permlane32_swap((unsigned)v, (unsigned)v, false, false);
    return (int)(rr[0] + rr[1]);
}
__device__ __forceinline__ int lane_id() { int l; asm volatile("v_mbcnt_lo_u32_b32 %0, -1, 0\n\tv_mbcnt_hi_u32_b32 %0, -1, %0" : "=v"(l)); return l; }
__device__ __forceinline__ int opaque_tid(int wave_s) { int t = wave_s * 64 + lane_id(); asm volatile("" : "+v"(t)); return t; }
__device__ __forceinline__ int opaque_int(int v) { asm volatile("" : "+s"(v)); return v; }
__device__ __forceinline__ unsigned cvt4_fp8(float a, float b, float c, float d) {
    a = __builtin_fminf(__builtin_fmaxf(a, -448.f), 448.f); b = __builtin_fminf(__builtin_fmaxf(b, -448.f), 448.f);
    c = __builtin_fminf(__builtin_fmaxf(c, -448.f), 448.f); d = __builtin_fminf(__builtin_fmaxf(d, -448.f), 448.f);
    int w = 0; w = __builtin_amdgcn_cvt_pk_fp8_f32(a, b, w, false); w = __builtin_amdgcn_cvt_pk_fp8_f32(c, d, w, true); return (unsigned)w; }
constexpr float W8_SCALE = 64.f, W8_INV = 1.f / 64.f;
#define DBL_MASK 0u
#define DBL_BAR 0
#define ATT_ABL 0
#define ATT_PRIO 4
#define PITCH_PAD 0
namespace pg8 {
#define PG8_LAS __attribute__((address_space(3)))
constexpr int BM = 256, BK = 64, HALF = 128, HTB = HALF * BK * 2  , STAGE_BYTES = 8 * HTB, NXCD = 8, WGM = 8;

__host__ __device__ __forceinline__ int lds_byte(int r, int c) { const int st = (r >> 4) * 2 + (c >> 5), rr = r & 15, cc = c & 31, ob = rr * 64 + cc * 2; return st * 1024 + (ob ^ (((ob >> 9) & 1) << 5)); }
__host__ __device__ __forceinline__ void stage_rc(int b, int& R, int& C) { const int st = b / 1024, sb = b % 1024, swz = sb ^ (((sb >> 9) & 1) << 5); R = (st >> 1) * 16 + swz / 64; C = (st & 1) * 32 + (swz % 64) / 2; }

typedef int i32x4v __attribute__((ext_vector_type(4)));
typedef int i32x8v __attribute__((ext_vector_type(8)));
__device__ __forceinline__ i32x8v cat8(bf16x8 lo, bf16x8 hi) { const i32x4v a = __builtin_bit_cast(i32x4v, lo), b = __builtin_bit_cast(i32x4v, hi); return __builtin_shufflevector(a, b, 0, 1, 2, 3, 4, 5, 6, 7); }
struct Unit { int pm, pn, e; };
struct Gemm { const void* A; const void* Bt; size_t bstride; int K; };

struct StaticOrder {
    int nM, nN, nwg, G, c;
    __device__ void init(int M, int N, int G_, int c_) { nM = M / BM; nN = N / BM; nwg = nM * nN; G = G_; c = c_; }
    __device__ bool next(int i, Unit& u) const {
        const long L = (long)i * G + c; if (L >= nwg) return false;
        int wgid = (int)L; { const int q = nwg / NXCD, r = nwg % NXCD, xcd = wgid % NXCD, off = wgid / NXCD; wgid = (xcd < r ? xcd * (q + 1) : r * (q + 1) + (xcd - r) * q) + off; }
        const int nig = WGM * nN, gid = wgid / nig, fm = gid * WGM, gsz = (nM - fm) < WGM ? (nM - fm) : WGM;
        u.pm = fm + ((wgid % nig) % gsz); u.pn = (wgid % nig) / gsz; u.e = 0; return true;
    }
    __device__ __forceinline__ void a_ready(const Unit&) const {}
    __device__ __forceinline__ void done(const Unit&) const {}
};
struct MoeOrder {
    int nM, nN, nwg, G, c; int pend[8];
    __device__ void init(const int* seg  , int N, int G_, int c_) {
#pragma unroll
        for (int e = 0; e < 8; ++e) pend[e] = __builtin_amdgcn_readfirstlane(seg[e + 1]) >> 8;
        nM = pend[7]; nN = N / BM; nwg = nM * nN; G = G_; c = c_; }
    __device__ void init_dense(int M, int N, int G_, int c_) {
#pragma unroll
        for (int e = 0; e < 8; ++e) pend[e] = 0x7fffffff;
        nM = M / BM; nN = N / BM; nwg = nM * nN; G = G_; c = c_; }
    __device__ bool next(int i, Unit& u) const {
        const long L = (long)i * G + c; if (L >= nwg) return false;
        int wgid = (int)L; { const int q = nwg / NXCD, r = nwg % NXCD, xcd = wgid % NXCD, off = wgid / NXCD; wgid = (xcd < r ? xcd * (q + 1) : r * (q + 1) + (xcd - r) * q) + off; }
        const int nig = WGM * nN, gid = wgid / nig, fm = gid * WGM, gsz = (nM - fm) < WGM ? (nM - fm) : WGM;
        u.pm = fm + ((wgid % nig) % gsz); u.pn = (wgid % nig) / gsz;
        int e = 0;
#pragma unroll
        for (int k = 0; k < 7; ++k) e += (u.pm >= pend[k]) ? 1 : 0;
        u.e = e; return true;
    }
    __device__ __forceinline__ void a_ready(const Unit&) const {}
    __device__ __forceinline__ void done(const Unit&) const {}
};


struct EpiQKV {
    static constexpr bool AFTER_DRAIN = false;
    bf16_t* Q; size_t qkv_stride; const float* rope;
    __device__ __forceinline__ void operator()(const f32x4 (&acc)[2][2][4][2], const Unit& u, int wr, int wc, int fr, int fq) const {
        const int which = u.pn >> 2;
        bf16_t* base = Q + (size_t)which * qkv_stride;
        const int col = (u.pn & 3) * 256 + wc * 32 + 8 * fq;
        const int row0 = u.pm * BM + wr * 64 + fr;
        const bool rot = (which < 2) && (u.pm < RL / BM);
        const float qs = which == 0 ? QSCALE : 1.f;
        const int axis = wc & 1;
#pragma unroll
        for (int ai = 0; ai < 2; ++ai)
#pragma unroll
            for (int m = 0; m < 4; ++m) {
                const int row = row0 + ai * HALF + m * 16;
                f32x4 cs = (f32x4){1.f, 1.f, 1.f, 1.f}, sn = (f32x4){0.f, 0.f, 0.f, 0.f};
                if (rot) { const int s = row & (SEQ - 1); const int pos = axis ? (s & 63) : (s >> 6);
                    cs = *(const f32x4*)(rope + pos * 16 + 4 * fq); sn = *(const f32x4*)(rope + 2048 + pos * 16 + 4 * fq); }
                cs = cs * qs; sn = sn * qs;
                bf16_t* rowp = base + (unsigned)(row * DM + col);
#pragma unroll
                for (int bj = 0; bj < 2; ++bj) {
                    const f32x4 x0 = acc[ai][bj][m][0], x1 = acc[ai][bj][m][1];
                    const f32x4 o0 = x0 * cs - x1 * sn, o1 = x1 * cs + x0 * sn;
                    u32x4 w; w.x = cvt_pk_bf16(o0[0], o0[1]); w.y = cvt_pk_bf16(o0[2], o0[3]); w.z = cvt_pk_bf16(o1[0], o1[1]); w.w = cvt_pk_bf16(o1[2], o1[3]);
                    *(u32x4*)(rowp + bj * HALF) = w; }
            }
    }
};
struct EpiResid {
    static constexpr bool AFTER_DRAIN = false;
    bf16_t* X; const float* g; float sc;
    __device__ __forceinline__ void operator()(const f32x4 (&acc)[2][2][4][2], const Unit& u, int wr, int wc, int fr, int fq) const {
        const int mi = u.pm < RL / BM ? (u.pm >> 5) : 4;
        const int col = u.pn * BM + wc * 32 + 4 * fq;
        const float* gp = g + (unsigned)(mi * 6144 + col);
        f32x4 gv[2][2];
#pragma unroll
        for (int bj = 0; bj < 2; ++bj)
#pragma unroll
            for (int n = 0; n < 2; ++n) gv[bj][n] = *(const f32x4*)(gp + bj * HALF + n * 16) * sc;
        const int row0 = u.pm * BM + wr * 64 + fr;
#pragma unroll
        for (int ai = 0; ai < 2; ++ai)
#pragma unroll
            for (int m = 0; m < 4; ++m) { bf16_t* rowp = X + (unsigned)((row0 + ai * HALF + m * 16) * DM + col);
#pragma unroll
                for (int bj = 0; bj < 2; ++bj)
#pragma unroll
                    for (int n = 0; n < 2; ++n) { const u32x2 o = *(const u32x2*)(rowp + bj * HALF + n * 16);
                        const f32x4 r = (f32x4){bf_lo(o.x), bf_hi(o.x), bf_lo(o.y), bf_hi(o.y)} + gv[bj][n] * acc[ai][bj][m][n];
                        u32x2 w; w.x = cvt_pk_bf16(r[0], r[1]); w.y = cvt_pk_bf16(r[2], r[3]); *(u32x2*)(rowp + bj * HALF + n * 16) = w; }
                asm volatile("" ::: "memory"); }
    }
};
template <bool F8OUT> struct EpiSwiGLU {
    static constexpr bool AFTER_DRAIN = false;
    void* O; int ldc; float sc;
    __device__ __forceinline__ void operator()(const f32x4 (&acc)[2][2][4][2], const Unit& u, int wr, int wc, int fr, int fq) const {
        const int col = u.pn * HALF + wc * 32 + 8 * fq;
        const int row0 = u.pm * BM + wr * 64 + fr;
#pragma unroll
        for (int ai = 0; ai < 2; ++ai)
#pragma unroll
            for (int m = 0; m < 4; ++m) {
                f32x4 v[2];
#pragma unroll
                for (int bj = 0; bj < 2; ++bj) { const f32x4 gt = acc[ai][bj][m][0], up = acc[ai][bj][m][1];
#pragma unroll
                    for (int j = 0; j < 4; j += 2) {
                        const f32x2 g2 = {gt[j], gt[j + 1]}, u2 = {up[j], up[j + 1]};
                        const f32x2 e2 = (f32x2){fast_exp2(g2.x), fast_exp2(g2.y)} + 1.f;
                        const f32x2 r2 = {fast_rcp(e2.x), fast_rcp(e2.y)};
                        const f32x2 o2 = (g2 * u2) * r2; v[bj][j] = o2.x; v[bj][j + 1] = o2.y; } }
                if constexpr (F8OUT) { u32x2 w; w.x = cvt4_fp8(v[0][0], v[0][1], v[0][2], v[0][3]); w.y = cvt4_fp8(v[1][0], v[1][1], v[1][2], v[1][3]);
                    *(u32x2*)((unsigned char*)O + (unsigned)((row0 + ai * HALF + m * 16) * ldc + col)) = w; }
                else { u32x4 w; w.x = cvt_pk_bf16(v[0][0], v[0][1]); w.y = cvt_pk_bf16(v[0][2], v[0][3]); w.z = cvt_pk_bf16(v[1][0], v[1][1]); w.w = cvt_pk_bf16(v[1][2], v[1][3]);
                    *(u32x4*)((bf16_t*)O + (unsigned)((row0 + ai * HALF + m * 16) * ldc + col)) = w; }
            }
    }
};
struct EpiWin {
    static constexpr bool AFTER_DRAIN = false;
    bf16_t* GATE; size_t p_stride;
    __device__ __forceinline__ void operator()(const f32x4 (&acc)[2][2][4][2], const Unit& u, int wr, int wc, int fr, int fq) const {
        const int which = u.pn >> 2;
        bf16_t* base = GATE + (size_t)which * p_stride;
        const int col = (u.pn & 3) * 256 + wc * 32 + 8 * fq;
        const int row0 = u.pm * BM + wr * 64 + fr;
#pragma unroll
        for (int ai = 0; ai < 2; ++ai)
#pragma unroll
            for (int m = 0; m < 4; ++m) { bf16_t* rowp = base + (unsigned)((row0 + ai * HALF + m * 16) * DM + col);
#pragma unroll
                for (int bj = 0; bj < 2; ++bj) { f32x4 v0 = acc[ai][bj][m][0], v1 = acc[ai][bj][m][1];
                    if (!which) {
#pragma unroll
                        for (int j = 0; j < 4; ++j) { const float x = v0[j], y = v1[j];
                            v0[j] = x * sigmoid_f(1.5957691216057308f * (x + 0.044715f * x * x * x));
                            v1[j] = y * sigmoid_f(1.5957691216057308f * (y + 0.044715f * y * y * y)); } }
                    u32x4 w; w.x = cvt_pk_bf16(v0[0], v0[1]); w.y = cvt_pk_bf16(v0[2], v0[3]); w.z = cvt_pk_bf16(v1[0], v1[1]); w.w = cvt_pk_bf16(v1[2], v1[3]);
                    *(u32x4*)(rowp + bj * HALF) = w; } }
    }
};
struct EpiBf16 {
    static constexpr bool AFTER_DRAIN = false;
    bf16_t* O; int ldc; float sc;
    __device__ __forceinline__ void operator()(const f32x4 (&acc)[2][2][4][2], const Unit& u, int wr, int wc, int fr, int fq) const {
        const int col = u.pn * BM + wc * 32 + 8 * fq;
        const int row0 = u.pm * BM + wr * 64 + fr;
#pragma unroll
        for (int ai = 0; ai < 2; ++ai)
#pragma unroll
            for (int m = 0; m < 4; ++m) { bf16_t* rowp = O + (unsigned)((row0 + ai * HALF + m * 16) * ldc + col);
#pragma unroll
                for (int bj = 0; bj < 2; ++bj) { const f32x4 v0 = acc[ai][bj][m][0], v1 = acc[ai][bj][m][1];
                    u32x4 w; w.x = cvt_pk_bf16(v0[0], v0[1]); w.y = cvt_pk_bf16(v0[2], v0[3]); w.z = cvt_pk_bf16(v1[0], v1[1]); w.w = cvt_pk_bf16(v1[2], v1[3]);
                    *(u32x4*)(rowp + bj * HALF) = w; } }
    }
};

template <class Epi, class Sched, bool ALIGN_EPI = false, bool SP2 = false, bool F8 = false>
__device__ __forceinline__ void gemm_phase(PG8_LAS unsigned char* lds, const Gemm g, const Sched& S, const Epi& E, int wave_s_) {
    const int tid = opaque_tid(wave_s_), wid = __builtin_amdgcn_readfirstlane(tid >> 6), lane = tid & 63, wr = wid >> 2, wc = wid & 3, fr = lane & 15, fq = lane >> 4;
    int sc127 = 0, sc121 = 0;
    if constexpr (F8) { asm volatile("v_mov_b32 %0, 0x7f7f7f7f" : "=v"(sc127)); asm volatile("v_mov_b32 %0, 0x79797979" : "=v"(sc121)); }
    const int Kb = F8 ? g.K : 2 * g.K, nt = Kb / 128;
    unsigned voffA[2], voffB[2];
#pragma unroll
    for (int i = 0; i < 2; ++i) { int R, C; stage_rc(tid * 16 + i * 8192, R, C); voffA[i] = (unsigned)(R * Kb + 2 * C); voffB[i] = voffA[i]; }
    const unsigned kstep = (unsigned)(BK * 2);
    const unsigned hstep = (unsigned)HALF * Kb;
    const unsigned tstep = 2 * hstep;
    const unsigned ldsw = (unsigned)wid * 1024u;
    const int aoff = lds_byte(wr * 64 + fr, fq * 8), boff = lds_byte(wc * 32 + fr, fq * 8);
#define PG8_SA(b, h) (((b) * 2 + (h)) * HTB)
#define PG8_SB(b, h) ((4 + (b) * 2 + (h)) * HTB)
#define PG8_RSRC_voffA rA
#define PG8_RSRC_voffB rB
#define PG8_STAGE(bufoff, goff, voff) do { _Pragma("unroll") for (int _i = 0; _i < 2; ++_i) \
        __builtin_amdgcn_raw_ptr_buffer_load_lds(PG8_RSRC_##voff, (PG8_LAS void*)(lds + (bufoff) + ldsw + _i * 8192), 16, (int)(voff)[_i], (int)(goff), 0, 0); } while (0)
#define PG8_LDA(dst, b, h) do { _Pragma("unroll") for (int m = 0; m < 4; ++m) _Pragma("unroll") for (int k = 0; k < 2; ++k) dst[m][k] = *(const PG8_LAS bf16x8*)(lds + PG8_SA(b, h) + aoff + m * 2048 + k * 1024); } while (0)
#define PG8_LDB(dst, b, h) do { _Pragma("unroll") for (int n = 0; n < 2; ++n) _Pragma("unroll") for (int k = 0; k < 2; ++k) dst[n][k] = *(const PG8_LAS bf16x8*)(lds + PG8_SB(b, h) + boff + n * 2048 + k * 1024); } while (0)
#define PG8_MMA(ai, bj, At, Bt) do { __builtin_amdgcn_s_setprio(1); _Pragma("unroll") for (int m = 0; m < 4; ++m) _Pragma("unroll") for (int n = 0; n < 2; ++n) { \
        if constexpr (F8) acc[ai][bj][m][n] = __builtin_amdgcn_mfma_scale_f32_16x16x128_f8f6f4(cat8(Bt[n][0], Bt[n][1]), cat8(At[m][0], At[m][1]), acc[ai][bj][m][n], 0, 0, 0, sc121, 0, sc127); \
        else { _Pragma("unroll") for (int k = 0; k < 2; ++k) acc[ai][bj][m][n] = __builtin_amdgcn_mfma_f32_16x16x32_bf16(Bt[n][k], At[m][k], acc[ai][bj][m][n], 0, 0, 0); } } __builtin_amdgcn_s_setprio(0); } while (0)
#define PG8_WAIT_V(n) asm volatile("s_waitcnt vmcnt(" #n ")" ::: "memory")
#define PG8_WAIT_L(n) asm volatile("s_waitcnt lgkmcnt(" #n ")" ::: "memory")
#define PG8_BAR __builtin_amdgcn_s_barrier()
#define PG8_SCHED __builtin_amdgcn_sched_barrier(0)
    Unit cur, nxt; int ui = 0;
    if (!S.next(0, cur)) return;
    f32x4 acc[2][2][4][2];
#pragma unroll
    for (int a = 0; a < 2; ++a)
#pragma unroll
        for (int b = 0; b < 2; ++b)
#pragma unroll
            for (int m = 0; m < 4; ++m)
#pragma unroll
                for (int n = 0; n < 2; ++n) acc[a][b][m][n] = (f32x4){0.f, 0.f, 0.f, 0.f};
    bf16x8 At[4][2], B0[2][2], B1[2][2];
    const __amdgpu_buffer_rsrc_t rA = __builtin_amdgcn_make_buffer_rsrc(const_cast<void*>(g.A), 0, 0x7fffffff, 0x00020000), rB = __builtin_amdgcn_make_buffer_rsrc(const_cast<void*>(g.Bt), 0, 0x7fffffff, 0x00020000);
    unsigned cA = (unsigned)cur.pm * tstep, cB = (unsigned)cur.e * (unsigned)g.bstride + (unsigned)cur.pn * tstep;
    S.a_ready(cur);
    if constexpr (SP2) {
        PG8_STAGE(PG8_SB(0, 0), cB, voffB); PG8_STAGE(PG8_SB(0, 1), cB + hstep, voffB); PG8_STAGE(PG8_SA(0, 0), cA, voffA); PG8_STAGE(PG8_SA(0, 1), cA + hstep, voffA);
        if (wr == 1) PG8_BAR;
        PG8_WAIT_V(2); PG8_BAR;
        PG8_STAGE(PG8_SB(1, 0), cB + kstep, voffB); PG8_STAGE(PG8_SA(1, 0), cA + kstep, voffA); PG8_STAGE(PG8_SB(1, 1), cB + hstep + kstep, voffB);
        PG8_WAIT_V(6); PG8_BAR;
    } else {
        PG8_STAGE(PG8_SB(0, 0), cB, voffB); PG8_STAGE(PG8_SA(0, 0), cA, voffA); PG8_STAGE(PG8_SB(0, 1), cB + hstep, voffB); PG8_STAGE(PG8_SA(0, 1), cA + hstep, voffA);
        if (wr == 1) PG8_BAR;
        PG8_WAIT_V(4); PG8_BAR;
        PG8_STAGE(PG8_SB(1, 0), cB + kstep, voffB); PG8_STAGE(PG8_SA(1, 0), cA + kstep, voffA); PG8_STAGE(PG8_SB(1, 1), cB + hstep + kstep, voffB);
        PG8_WAIT_V(6); PG8_BAR;
    }
    for (;;) {
        const bool has_next = S.next(ui + 1, nxt);
        const unsigned nA = has_next ? (unsigned)nxt.pm * tstep : cA, nB = has_next ? (unsigned)nxt.e * (unsigned)g.bstride + (unsigned)nxt.pn * tstep : cB;
#pragma nounroll
        for (int t = 0; t < nt; t += 2) {
            const bool last = (t == nt - 2);
            const unsigned a1 = cA + (unsigned)(t + 1) * kstep;
            const unsigned a2 = last ? nA : cA + (unsigned)(t + 2) * kstep, b2 = last ? nB : cB + (unsigned)(t + 2) * kstep;
            const unsigned a3 = a2 + kstep, b3 = b2 + kstep;
            if (last && has_next) S.a_ready(nxt);
            if constexpr (SP2) {
            PG8_LDB(B0, 0, 0); PG8_LDB(B1, 0, 1); PG8_SCHED; PG8_LDA(At, 0, 0); PG8_STAGE(PG8_SA(1, 1), a1 + hstep, voffA);
            PG8_WAIT_V(8); PG8_WAIT_L(0); PG8_BAR; PG8_MMA(0, 0, At, B0); PG8_MMA(0, 1, At, B1); PG8_BAR; PG8_SCHED;
            PG8_LDA(At, 0, 1); PG8_STAGE(PG8_SB(0, 0), b2, voffB); PG8_STAGE(PG8_SB(0, 1), b2 + hstep, voffB); PG8_STAGE(PG8_SA(0, 0), a2, voffA);
            PG8_WAIT_V(8); PG8_WAIT_L(0); PG8_BAR; PG8_MMA(1, 0, At, B0); PG8_MMA(1, 1, At, B1); PG8_BAR; PG8_SCHED;
            PG8_LDB(B0, 1, 0); PG8_LDB(B1, 1, 1); PG8_SCHED; PG8_LDA(At, 1, 0); PG8_STAGE(PG8_SA(0, 1), a2 + hstep, voffA);
            PG8_WAIT_V(8); PG8_WAIT_L(0); PG8_BAR; PG8_MMA(0, 0, At, B0); PG8_MMA(0, 1, At, B1); PG8_BAR; PG8_SCHED;
            PG8_LDA(At, 1, 1); PG8_STAGE(PG8_SB(1, 0), b3, voffB); PG8_STAGE(PG8_SB(1, 1), b3 + hstep, voffB); PG8_STAGE(PG8_SA(1, 0), a3, voffA);
            PG8_WAIT_V(8); PG8_WAIT_L(0); PG8_BAR; PG8_MMA(1, 0, At, B0); PG8_MMA(1, 1, At, B1); PG8_BAR; PG8_SCHED;
            } else {
            PG8_LDB(B0, 0, 0); PG8_SCHED; PG8_LDA(At, 0, 0); PG8_STAGE(PG8_SA(1, 1), a1 + hstep, voffA);
            PG8_WAIT_L(8); PG8_BAR; PG8_WAIT_L(0); PG8_MMA(0, 0, At, B0); PG8_BAR; PG8_SCHED;
            PG8_LDB(B1, 0, 1); PG8_STAGE(PG8_SB(0, 0), b2, voffB);
            PG8_BAR; PG8_WAIT_L(0); PG8_MMA(0, 1, At, B1); PG8_BAR;
            PG8_LDA(At, 0, 1); PG8_STAGE(PG8_SA(0, 0), a2, voffA);
            PG8_BAR; PG8_WAIT_L(0); PG8_MMA(1, 0, At, B0); PG8_BAR; PG8_SCHED;
            PG8_STAGE(PG8_SB(0, 1), b2 + hstep, voffB);
            PG8_WAIT_V(6); PG8_BAR; PG8_MMA(1, 1, At, B1); PG8_BAR;
            PG8_LDB(B0, 1, 0); PG8_SCHED; PG8_LDA(At, 1, 0); PG8_STAGE(PG8_SA(0, 1), a2 + hstep, voffA);
            PG8_WAIT_L(8); PG8_BAR; PG8_WAIT_L(0); PG8_MMA(0, 0, At, B0); PG8_BAR; PG8_SCHED;
            PG8_LDB(B1, 1, 1); PG8_STAGE(PG8_SB(1, 0), b3, voffB);
            PG8_BAR; PG8_WAIT_L(0); PG8_MMA(0, 1, At, B1); PG8_BAR;
            PG8_LDA(At, 1, 1); PG8_STAGE(PG8_SA(1, 0), a3, voffA);
            PG8_BAR; PG8_WAIT_L(0); PG8_MMA(1, 0, At, B0); PG8_BAR; PG8_SCHED;
            PG8_STAGE(PG8_SB(1, 1), b3 + hstep, voffB);
            PG8_WAIT_V(6); PG8_BAR; PG8_MMA(1, 1, At, B1); PG8_BAR;
            }
        }
        if constexpr (ALIGN_EPI) { if (wr == 0) PG8_BAR; }
        if constexpr (!Epi::AFTER_DRAIN) { E(acc, cur, wr, wc, fr, fq); S.done(cur); }
        if (!has_next) break;
#pragma unroll
        for (int a = 0; a < 2; ++a)
#pragma unroll
            for (int b = 0; b < 2; ++b)
#pragma unroll
                for (int m = 0; m < 4; ++m)
#pragma unroll
                    for (int n = 0; n < 2; ++n) acc[a][b][m][n] = (f32x4){0.f, 0.f, 0.f, 0.f};
        cur = nxt; cA = nA; cB = nB; ++ui;
        if constexpr (ALIGN_EPI) { if (wr == 1) PG8_BAR; }
    }
    PG8_WAIT_V(0);
    if constexpr (!ALIGN_EPI) { if (wr == 0) PG8_BAR; }
    PG8_BAR;
    if constexpr (Epi::AFTER_DRAIN) { E.fused(acc, cur, wr, wc, fr, fq, lds, wid, lane); S.done(cur); }
#undef PG8_SA
#undef PG8_SB
#undef PG8_STAGE
#undef PG8_RSRC_voffA
#undef PG8_RSRC_voffB
#undef PG8_LDA
#undef PG8_LDB
#undef PG8_MMA
#undef PG8_WAIT_V
#undef PG8_WAIT_L
#undef PG8_BAR
#undef PG8_SCHED
}
}

namespace att {
constexpr int KVBLK = 64;
constexpr int KSLOT = 8192, VSLOT = 16384;
constexpr int OFF_K = 0, OFF_V = 3 * KSLOT, OFF_WS = OFF_V + 4 * VSLOT, ATT_LDS = OFF_WS + 8 * 64 * 4;
static_assert(ATT_LDS <= RING_BYTES, "attention LDS");
constexpr float THRL = 8.f * 1.4426950408889634f;
#define SBAR() __builtin_amdgcn_sched_barrier(0)
#define __syncthreads() do { asm volatile("s_waitcnt lgkmcnt(0)" ::: "memory"); __builtin_amdgcn_s_barrier(); asm volatile("" ::: "memory"); } while (0)
#define ATT_PIN(x) asm volatile("" : "+v"(x))
#define ATT_WAIT_BAR(N) asm volatile("s_waitcnt vmcnt(" #N ") lgkmcnt(0)\n\ts_barrier" ::: "memory")
#define ATT_MFMA(a, b, c) __builtin_amdgcn_mfma_f32_32x32x16_bf16(a, b, c, 0, 0, 0)
__device__ __forceinline__ int crow(int r, int hi) { return (r & 3) + 8 * (r >> 2) + 4 * hi; }
__device__ __forceinline__ unsigned cvtpk(float lo, float hi) { unsigned r; asm("v_cvt_pk_bf16_f32 %0, %1, %2" : "=v"(r) : "v"(lo), "v"(hi)); return r; }
typedef const LAS char* lds_cptr;
typedef short v4i16_t __attribute__((ext_vector_type(4)));
__device__ __forceinline__ s16x4 vtr(lds_cptr p) { return __builtin_bit_cast(s16x4, __builtin_amdgcn_ds_read_tr16_b64_v4i16((LAS v4i16_t*)p)); }
__device__ __forceinline__ bf16x8 kld(lds_cptr p) { return *(const LAS bf16x8*)p; }
#define ATT_MX3(a, b, c) __builtin_fmaxf(__builtin_fmaxf((a), (b)), (c))
__device__ __forceinline__ float rowmax(const f32x16& p0, const f32x16& p1) {
  float a = ATT_MX3(p0[0], p0[1], p1[0]), b = ATT_MX3(p0[2], p0[3], p1[1]); a = ATT_MX3(a, p1[2], p1[3]);
#pragma unroll
  for (int r = 4; r < 16; r += 4) { a = ATT_MX3(a, p0[r], p0[r + 1]); b = ATT_MX3(b, p0[r + 2], p0[r + 3]); a = ATT_MX3(a, p1[r], p1[r + 1]); b = ATT_MX3(b, p1[r + 2], p1[r + 3]); }
  const float m = __builtin_fmaxf(a, b); const auto rr = __builtin_amdgcn_permlane32_swap(__float_as_uint(m), __float_as_uint(m), false, false);
  return __builtin_fmaxf(__uint_as_float(rr[0]), __uint_as_float(rr[1]));
}

struct AttnArgs { const bf16_t* Q; const bf16_t* K; const bf16_t* V; bf16_t* O; float* stash; const float* subln_g; float lam, oscale; };

typedef __amdgpu_buffer_rsrc_t rsrc_t;
__device__ __forceinline__ rsrc_t mk_rsrc(const void* p) { return __builtin_amdgcn_make_buffer_rsrc(const_cast<void*>(p), 0, 0x7fffffff, 0x00020000); }
__device__ __forceinline__ bf16x8 bld16(rsrc_t r, unsigned voff, unsigned soff) { const u32x4 v = __builtin_amdgcn_raw_buffer_load_b128(r, (int)voff, (int)soff, 0); return __builtin_bit_cast(bf16x8, v); }

__device__ __forceinline__ u32x4 mk_rsrc4(const void* p) { const unsigned long long a = (unsigned long long)p; return u32x4{(unsigned)a, (unsigned)(a >> 32) & 0xffffu, 0x7fffffffu, 0x00020000u}; }
__device__ __forceinline__ void dma16(u32x4 rsrc, unsigned voff, unsigned soff, unsigned lds_addr) {
  unsigned sv; asm volatile("s_mov_b32 %0, m0\n\ts_mov_b32 m0, %4\n\ts_nop 0\n\tbuffer_load_dwordx4 %1, %2, %3 offen lds\n\ts_mov_b32 m0, %0" : "=&s"(sv) : "v"(voff), "s"(rsrc), "s"(soff), "s"(lds_addr) : "memory"); }

__device__ __forceinline__ void attn_unit(LAS char* lds, const AttnArgs& A, int qrow0, int h, int klat0, int kctx0, int nlat, int NT, int wave_s_) {
  const int tid = opaque_tid(wave_s_), wid = __builtin_amdgcn_readfirstlane(tid >> 6), lane = tid & 63, r32 = lane & 31, hi = lane >> 5;
  LAS float* wsf = (LAS float*)(lds + OFF_WS) + wid * 64; LAS float* li_l = wsf + 32;
  const lds_cptr kp0 = (lds_cptr)lds + OFF_K + hi * 1024 + r32 * 16;
  const lds_cptr vp0 = (lds_cptr)lds + OFF_V + ((lane >> 4) & 1) * 32 + (lane & 3) * 8 + (4 * hi + ((lane & 15) >> 2)) * 64;
  const unsigned lds0 = (unsigned)(size_t)lds; const unsigned kdst = lds0 + OFF_K + wid * 1024, vdst = lds0 + OFF_V + wid * 1024;
  const unsigned qoff = (unsigned)(r32 * DM + h * 128 + hi * 8) * 2u;
  const unsigned kvo = (unsigned)(lane * DM + h * 128 + wid * 8) * 2u;
  const unsigned vvo = (unsigned)((16 * (wid & 3) + (lane >> 2)) * DM + h * 128 + (wid >> 2) * 32 + (lane & 3) * 8) * 2u;
  const rsrc_t rQ = mk_rsrc(A.Q), rO = mk_rsrc(A.O), rS = mk_rsrc(A.stash); const u32x4 rK4 = mk_rsrc4(A.K), rV4 = mk_rsrc4(A.V);
  const unsigned stash_s = (unsigned)blockIdx.x * (64u * 512u * 4u);
  const unsigned soff = (unsigned)tid * 4u;
#define KROWB(t) ((unsigned)((t) < nlat ? klat0 + (t) * KVBLK : kctx0 + ((t) - nlat) * KVBLK) * (unsigned)(DM * 2))
#define DMA_K(t, ks_) do { const int t_ = (t) < NT ? (t) : NT - 1; dma16(rK4, kvo, KROWB(t_) + ksw, kdst + (unsigned)(ks_)); } while (0)
#define DMA_V1(t, vo_) do { const int t_ = (t) < NT ? (t) : NT - 1; dma16(rV4, vvo, KROWB(t_), vdst + (vo_)); } while (0)
#define DMA_V2(t, vo_) do { const int t_ = (t) < NT ? (t) : NT - 1; dma16(rV4, vvo, KROWB(t_) + 128u, vdst + (vo_) + 8192u); } while (0)
#define VS(t) ((unsigned)((t) & 3) * (unsigned)VSLOT)
#define KRD(j, kp_) kf[j] = kld((kp_) + ((j) >> 1) * 2048 + ((j) & 1) * 512)
#define VRD(f, vp_) do { vlo[f] = vtr((vp_) + (((f) & 3) * 4096 + ((f) >> 2) * 1024)); vhi[f] = vtr((vp_) + (((f) & 3) * 4096 + ((f) >> 2) * 1024 + 512)); } while (0)
#define VFR(f) (bf16x8){vlo[f][0], vlo[f][1], vlo[f][2], vlo[f][3], vhi[f][0], vhi[f][1], vhi[f][2], vhi[f][3]}
#define PAF(k) __builtin_bit_cast(bf16x8, pw[k])
#define RESC() do { if (__builtin_expect(resc, 0)) { asm volatile("s_waitcnt lgkmcnt(0)" ::: "memory"); _Pragma("unroll") for (int d_ = 0; d_ < 4; ++d_) _Pragma("unroll") for (int r = 0; r < 16; ++r) o[d_][r] *= wsf[crow(r, hi)]; } } while (0)
  for (int sw = 0; sw < 2; ++sw) {
    const unsigned ksw = (unsigned)sw * 128u;
    bf16x8 qr[4];
    { const unsigned qs = (unsigned)((qrow0 + wid * 32) * DM + sw * 64) * 2u;
#pragma unroll
      for (int d0 = 0; d0 < 4; ++d0) qr[d0] = bld16(rQ, qoff, qs + d0 * 32); }
    DMA_K(0, 0u); DMA_V1(0, VS(0)); DMA_V2(0, VS(0)); DMA_K(1, (unsigned)KSLOT); DMA_K(2, 2u * KSLOT); DMA_V1(1, VS(1)); DMA_V2(1, VS(1));
    float mhat, l_reg; f32x16 o[4] = {}; f32x16 CA[2], CB[2]; f32x16 negm; bf16x8 kf[8]; s16x4 vlo[16], vhi[16]; u32x4 pw[4]; bool resc = false;
    ATT_WAIT_BAR(6);
#pragma unroll
    for (int j = 0; j < 8; ++j) KRD(j, kp0);
    CA[0] = ATT_MFMA(kf[0], qr[0], f32x16{}); CA[1] = ATT_MFMA(kf[1], qr[0], f32x16{});
#pragma unroll
    for (int j = 2; j < 8; ++j) CA[j & 1] = ATT_MFMA(kf[j], qr[j >> 1], CA[j & 1]);
    { mhat = rowmax(CA[0], CA[1]);
#pragma unroll
      for (int r = 0; r < 16; ++r) { negm[r] = -mhat; CA[0][r] = __builtin_amdgcn_exp2f(CA[0][r] - mhat); CA[1][r] = __builtin_amdgcn_exp2f(CA[1][r] - mhat); }
      ATT_PIN(negm);
      float s0 = 0.f, s1 = 0.f;
#pragma unroll
      for (int r = 0; r < 16; ++r) { s0 += CA[0][r]; s1 += CA[1][r]; }
      l_reg = s0 + s1;
#pragma unroll
      for (int w = 0; w < 16; ++w) pw[w >> 2][w & 3] = cvtpk(CA[(2 * w) >> 4][(2 * w) & 15], CA[(2 * w + 1) >> 4][(2 * w + 1) & 15]); }
    ATT_WAIT_BAR(0);
    DMA_K(3, 0u); DMA_V1(2, VS(2)); DMA_V2(2, VS(2));
#pragma unroll
    for (int j = 0; j < 8; ++j) KRD(j, kp0 + KSLOT);
    CB[0] = ATT_MFMA(kf[0], qr[0], negm); CB[1] = ATT_MFMA(kf[1], qr[0], negm);
#pragma unroll
    for (int j = 2; j < 8; ++j) CB[j & 1] = ATT_MFMA(kf[j], qr[j >> 1], CB[j & 1]);
    { const float rm = rowmax(CB[0], CB[1]);
      if (__builtin_expect(__any(rm > THRL), 0)) { const float dl = __builtin_fmaxf(rm, 0.f); mhat += dl;
#pragma unroll
        for (int r = 0; r < 16; ++r) { CB[0][r] -= dl; CB[1][r] -= dl; negm[r] = -mhat; }
        ATT_PIN(negm);
        const float f = __builtin_amdgcn_exp2f(-dl); l_reg *= f; if (hi == 0) wsf[r32] = f; resc = true; } }
    { const lds_cptr v0_ = vp0 + VS(0); VRD(0, v0_); VRD(1, v0_); VRD(2, v0_); }
    ATT_WAIT_BAR(3);
    unsigned kc_ = KSLOT;
#if ATT_PRIO == 1
    if (wid >= 4) __builtin_amdgcn_s_setprio(1);
#elif ATT_PRIO == 4
    if (wid < 4) __builtin_amdgcn_s_setprio(1);
#elif ATT_PRIO == 5
    if (wid < 4) __builtin_amdgcn_s_setprio(3);
#elif ATT_PRIO == 6
    if (wid & 1) __builtin_amdgcn_s_setprio(1);
#elif ATT_PRIO == 7
    __builtin_amdgcn_s_setprio(1);
#elif ATT_PRIO == 8
    __builtin_amdgcn_s_setprio(3);
#endif
#define ATT_STEP(CC, CN, t, LAST, DOMAX) do { SBAR(); \
    const unsigned k_rd_ = (kc_ == 2u * KSLOT) ? 0u : kc_ + KSLOT;                         \
    const lds_cptr vp_ = vp0 + VS((t) - 1); const lds_cptr vn_ = vp0 + VS(t); const lds_cptr kp_ = kp0 + k_rd_; float ma_ = 0.f, mb_ = 0.f; \
      VRD(3, vp_); SBAR(); o[0] = ATT_MFMA(PAF(0), VFR(0), o[0]); CC[0][0] = __builtin_amdgcn_exp2f(CC[0][0]); CC[0][1] = __builtin_amdgcn_exp2f(CC[0][1]); ATT_PIN(CC[0]); SBAR(); \
      DMA_K((t) + 3, kc_); VRD(4, vp_); SBAR(); o[1] = ATT_MFMA(PAF(0), VFR(1), o[1]); CC[0][2] = __builtin_amdgcn_exp2f(CC[0][2]); CC[0][3] = __builtin_amdgcn_exp2f(CC[0][3]); l_reg += CC[0][0]; l_reg += CC[0][1]; ATT_PIN(CC[0]); ATT_PIN(l_reg); SBAR(); \
      VRD(5, vp_); SBAR(); o[2] = ATT_MFMA(PAF(0), VFR(2), o[2]); CC[0][4] = __builtin_amdgcn_exp2f(CC[0][4]); CC[0][5] = __builtin_amdgcn_exp2f(CC[0][5]); l_reg += CC[0][2]; l_reg += CC[0][3]; ATT_PIN(CC[0]); ATT_PIN(l_reg); SBAR(); \
      VRD(6, vp_); SBAR(); o[3] = ATT_MFMA(PAF(0), VFR(3), o[3]); CC[0][6] = __builtin_amdgcn_exp2f(CC[0][6]); CC[0][7] = __builtin_amdgcn_exp2f(CC[0][7]); l_reg += CC[0][4]; l_reg += CC[0][5]; ATT_PIN(CC[0]); ATT_PIN(l_reg); SBAR(); \
      VRD(7, vp_); SBAR(); o[0] = ATT_MFMA(PAF(1), VFR(4), o[0]); CC[0][8] = __builtin_amdgcn_exp2f(CC[0][8]); CC[0][9] = __builtin_amdgcn_exp2f(CC[0][9]); l_reg += CC[0][6]; l_reg += CC[0][7]; pw[0][0] = cvtpk(CC[0][0], CC[0][1]); ATT_PIN(CC[0]); ATT_PIN(l_reg); ATT_PIN(pw[0]); SBAR(); \
      if (!(LAST)) KRD(0, kp_); SBAR(); o[1] = ATT_MFMA(PAF(1), VFR(5), o[1]); CC[0][10] = __builtin_amdgcn_exp2f(CC[0][10]); CC[0][11] = __builtin_amdgcn_exp2f(CC[0][11]); l_reg += CC[0][8]; l_reg += CC[0][9]; pw[0][1] = cvtpk(CC[0][2], CC[0][3]); ATT_PIN(CC[0]); ATT_PIN(l_reg); ATT_PIN(pw[0]); SBAR(); \
      if (!(LAST)) KRD(2, kp_); SBAR(); o[2] = ATT_MFMA(PAF(1), VFR(6), o[2]); CC[0][12] = __builtin_amdgcn_exp2f(CC[0][12]); CC[0][13] = __builtin_amdgcn_exp2f(CC[0][13]); l_reg += CC[0][10]; l_reg += CC[0][11]; pw[0][2] = cvtpk(CC[0][4], CC[0][5]); ATT_PIN(CC[0]); ATT_PIN(l_reg); ATT_PIN(pw[0]); SBAR(); \
      if (!(LAST)) KRD(4, kp_); SBAR(); o[3] = ATT_MFMA(PAF(1), VFR(7), o[3]); CC[0][14] = __builtin_amdgcn_exp2f(CC[0][14]); CC[0][15] = __builtin_amdgcn_exp2f(CC[0][15]); l_reg += CC[0][12]; l_reg += CC[0][13]; pw[0][3] = cvtpk(CC[0][6], CC[0][7]); ATT_PIN(CC[0]); ATT_PIN(l_reg); ATT_PIN(pw[0]); SBAR(); \
      if (!(LAST)) KRD(6, kp_); SBAR(); if (!(LAST)) CN[0] = ATT_MFMA(kf[0], qr[0], negm); CC[1][0] = __builtin_amdgcn_exp2f(CC[1][0]); CC[1][1] = __builtin_amdgcn_exp2f(CC[1][1]); l_reg += CC[0][14]; l_reg += CC[0][15]; pw[1][0] = cvtpk(CC[0][8], CC[0][9]); ATT_PIN(CC[1]); ATT_PIN(l_reg); ATT_PIN(pw[1]); SBAR(); \
      DMA_V1((t) + 2, VS((t) + 2)); if (!(LAST)) KRD(1, kp_); SBAR(); if (!(LAST)) CN[0] = ATT_MFMA(kf[2], qr[1], CN[0]); CC[1][2] = __builtin_amdgcn_exp2f(CC[1][2]); CC[1][3] = __builtin_amdgcn_exp2f(CC[1][3]); l_reg += CC[1][0]; l_reg += CC[1][1]; pw[1][1] = cvtpk(CC[0][10], CC[0][11]); ATT_PIN(CC[1]); ATT_PIN(l_reg); ATT_PIN(pw[1]); SBAR(); \
      if (!(LAST)) KRD(3, kp_); SBAR(); if (!(LAST)) CN[0] = ATT_MFMA(kf[4], qr[2], CN[0]); CC[1][4] = __builtin_amdgcn_exp2f(CC[1][4]); CC[1][5] = __builtin_amdgcn_exp2f(CC[1][5]); l_reg += CC[1][2]; l_reg += CC[1][3]; pw[1][2] = cvtpk(CC[0][12], CC[0][13]); ATT_PIN(CC[1]); ATT_PIN(l_reg); ATT_PIN(pw[1]); SBAR(); \
      if (!(LAST)) KRD(5, kp_); SBAR(); if (!(LAST)) CN[0] = ATT_MFMA(kf[6], qr[3], CN[0]); CC[1][6] = __builtin_amdgcn_exp2f(CC[1][6]); CC[1][7] = __builtin_amdgcn_exp2f(CC[1][7]); l_reg += CC[1][4]; l_reg += CC[1][5]; pw[1][3] = cvtpk(CC[0][14], CC[0][15]); ATT_PIN(CC[1]); ATT_PIN(l_reg); ATT_PIN(pw[1]); SBAR(); \
      if (!(LAST)) KRD(7, kp_); SBAR(); if (!(LAST)) CN[1] = ATT_MFMA(kf[1], qr[0], negm); CC[1][8] = __builtin_amdgcn_exp2f(CC[1][8]); CC[1][9] = __builtin_amdgcn_exp2f(CC[1][9]); l_reg += CC[1][6]; l_reg += CC[1][7]; ATT_PIN(CC[1]); ATT_PIN(l_reg); SBAR(); \
      VRD(8, vp_); SBAR(); if (!(LAST)) CN[1] = ATT_MFMA(kf[3], qr[1], CN[1]); CC[1][10] = __builtin_amdgcn_exp2f(CC[1][10]); CC[1][11] = __builtin_amdgcn_exp2f(CC[1][11]); l_reg += CC[1][8]; l_reg += CC[1][9]; if (!(LAST) && (DOMAX)) { ma_ = ATT_MX3(CN[0][0], CN[0][1], CN[0][2]); mb_ = ATT_MX3(CN[0][3], CN[0][4], CN[0][5]); ATT_PIN(ma_); ATT_PIN(mb_); } ATT_PIN(CC[1]); ATT_PIN(l_reg); SBAR(); \
      VRD(9, vp_); SBAR(); if (!(LAST)) CN[1] = ATT_MFMA(kf[5], qr[2], CN[1]); CC[1][12] = __builtin_amdgcn_exp2f(CC[1][12]); CC[1][13] = __builtin_amdgcn_exp2f(CC[1][13]); l_reg += CC[1][10]; l_reg += CC[1][11]; if (!(LAST) && (DOMAX)) { ma_ = ATT_MX3(ma_, CN[0][6], CN[0][7]); mb_ = ATT_MX3(mb_, CN[0][8], CN[0][9]); ATT_PIN(ma_); ATT_PIN(mb_); } ATT_PIN(CC[1]); ATT_PIN(l_reg); SBAR(); \
      VRD(10, vp_); SBAR(); if (!(LAST)) CN[1] = ATT_MFMA(kf[7], qr[3], CN[1]); CC[1][14] = __builtin_amdgcn_exp2f(CC[1][14]); CC[1][15] = __builtin_amdgcn_exp2f(CC[1][15]); l_reg += CC[1][12]; l_reg += CC[1][13]; if (!(LAST) && (DOMAX)) { ma_ = ATT_MX3(ma_, CN[0][10], CN[0][11]); mb_ = ATT_MX3(mb_, CN[0][12], CN[0][13]); ATT_PIN(ma_); ATT_PIN(mb_); } ATT_PIN(CC[1]); ATT_PIN(l_reg); SBAR(); \
      VRD(11, vp_); SBAR(); o[0] = ATT_MFMA(PAF(2), VFR(8), o[0]); l_reg += CC[1][14]; l_reg += CC[1][15]; if (!(LAST) && (DOMAX)) { ma_ = ATT_MX3(ma_, CN[0][14], CN[0][15]); ATT_PIN(ma_); ATT_PIN(mb_); } ATT_PIN(l_reg); SBAR(); \
      DMA_V2((t) + 2, VS((t) + 2)); VRD(12, vp_); SBAR(); o[1] = ATT_MFMA(PAF(2), VFR(9), o[1]); if (!(LAST) && (DOMAX)) { mb_ = ATT_MX3(mb_, CN[1][0], CN[1][1]); ma_ = ATT_MX3(ma_, CN[1][2], CN[1][3]); ATT_PIN(ma_); ATT_PIN(mb_); } SBAR(); \
      VRD(13, vp_); SBAR(); o[2] = ATT_MFMA(PAF(2), VFR(10), o[2]); if (!(LAST) && (DOMAX)) { mb_ = ATT_MX3(mb_, CN[1][4], CN[1][5]); ma_ = ATT_MX3(ma_, CN[1][6], CN[1][7]); ATT_PIN(ma_); ATT_PIN(mb_); } SBAR(); \
      VRD(14, vp_); SBAR(); o[3] = ATT_MFMA(PAF(2), VFR(11), o[3]); if (!(LAST) && (DOMAX)) { mb_ = ATT_MX3(mb_, CN[1][8], CN[1][9]); ma_ = ATT_MX3(ma_, CN[1][10], CN[1][11]); ATT_PIN(ma_); ATT_PIN(mb_); } SBAR(); \
      VRD(15, vp_); SBAR(); o[0] = ATT_MFMA(PAF(3), VFR(12), o[0]); pw[2][0] = cvtpk(CC[1][0], CC[1][1]); if (!(LAST) && (DOMAX)) { mb_ = ATT_MX3(mb_, CN[1][12], CN[1][13]); ma_ = ATT_MX3(ma_, CN[1][14], CN[1][15]); ATT_PIN(ma_); ATT_PIN(mb_); } ATT_PIN(pw[2]); SBAR(); \
      VRD(0, vn_); SBAR(); o[1] = ATT_MFMA(PAF(3), VFR(13), o[1]); pw[2][1] = cvtpk(CC[1][2], CC[1][3]); ATT_PIN(pw[2]); SBAR(); \
      VRD(1, vn_); SBAR(); o[2] = ATT_MFMA(PAF(3), VFR(14), o[2]); pw[2][2] = cvtpk(CC[1][4], CC[1][5]); ATT_PIN(pw[2]); SBAR(); \
      VRD(2, vn_); SBAR(); o[3] = ATT_MFMA(PAF(3), VFR(15), o[3]); pw[2][3] = cvtpk(CC[1][6], CC[1][7]); ATT_PIN(pw[2]); SBAR(); \
    pw[3][0] = cvtpk(CC[1][8], CC[1][9]); pw[3][1] = cvtpk(CC[1][10], CC[1][11]); pw[3][2] = cvtpk(CC[1][12], CC[1][13]); pw[3][3] = cvtpk(CC[1][14], CC[1][15]); \
    RESC(); resc = false;                                      \
    if (!(LAST) && (DOMAX)) { float rm = __builtin_fmaxf(ma_, mb_); { const auto rr_ = __builtin_amdgcn_permlane32_swap(__float_as_uint(rm), __float_as_uint(rm), false, false); rm = __builtin_fmaxf(__uint_as_float(rr_[0]), __uint_as_float(rr_[1])); } \
      if (__builtin_expect(__any(rm > THRL), 0)) { const float dl = __builtin_fmaxf(rm, 0.f); mhat += dl;        \
        _Pragma("unroll") for (int r = 0; r < 16; ++r) { CN[0][r] -= dl; CN[1][r] -= dl; negm[r] = -mhat; } \
        ATT_PIN(negm); \
        const float f = __builtin_amdgcn_exp2f(-dl); l_reg *= f; if (hi == 0) wsf[r32] = f; resc = true; } } \
    kc_ = k_rd_; } while (0)
#pragma nounroll
    for (int t = 1; t + 1 < NT; t += 2) {
      ATT_STEP(CB, CA, t, false, false); ATT_WAIT_BAR(3);
      ATT_STEP(CA, CB, t + 1, false, true); ATT_WAIT_BAR(3);
    }
    ATT_STEP(CB, CA, NT - 1, true, false);
#if ATT_PRIO
    __builtin_amdgcn_s_setprio(0);
#endif
    { const lds_cptr vpp = vp0 + VS(NT - 1);
#define DR(f) VRD(f, vpp)
      DR(0); DR(1); DR(2); DR(3); DR(4); DR(5); DR(6); DR(7); DR(8); DR(9); DR(10); DR(11); DR(12); DR(13); DR(14); DR(15);
#undef DR
#define DM_(g) o[(g) & 3] = ATT_MFMA(PAF((g) >> 2), VFR(g), o[(g) & 3])
      DM_(0); DM_(1); DM_(2); DM_(3); DM_(4); DM_(5); DM_(6); DM_(7); DM_(8); DM_(9); DM_(10); DM_(11); DM_(12); DM_(13); DM_(14); DM_(15);
#undef DM_
    }
#undef ATT_STEP
    ATT_WAIT_BAR(0);
    { const auto rr = __builtin_amdgcn_permlane32_swap(__float_as_uint(l_reg), __float_as_uint(l_reg), false, false); l_reg = __uint_as_float(rr[0]) + __uint_as_float(rr[1]); }
    if (hi == 0) li_l[r32] = l_reg; asm volatile("s_waitcnt lgkmcnt(0)" ::: "memory");
    float rli[16];
#pragma unroll
    for (int r = 0; r < 16; ++r) rli[r] = __builtin_amdgcn_rcpf(li_l[crow(r, hi)]);
    if (sw == 0) {
#pragma unroll
      for (int d0 = 0; d0 < 4; ++d0) {
#pragma unroll
        for (int r = 0; r < 16; ++r) __builtin_amdgcn_raw_buffer_store_b32(__float_as_uint(o[d0][r] * rli[r]), rS, (int)soff, (int)(stash_s + (d0 * 16 + r) * 2048), 0);
        asm volatile("" ::: "memory"); }
    } else {
      float ss[16];
#pragma unroll
      for (int r = 0; r < 16; ++r) ss[r] = 0.f;
#pragma unroll
      for (int d0 = 0; d0 < 4; ++d0) {
#pragma unroll
        for (int r = 0; r < 16; ++r) { const float v = __uint_as_float(__builtin_amdgcn_raw_buffer_load_b32(rS, (int)soff, (int)(stash_s + (d0 * 16 + r) * 2048), 0)) - A.lam * (o[d0][r] * rli[r]); o[d0][r] = v; ss[r] += v * v; }
        asm volatile("" ::: "memory"); }
#pragma unroll
      for (int r = 0; r < 16; ++r) {
        ss[r] += xor_swz<1>(ss[r]); ss[r] += xor_swz<2>(ss[r]); ss[r] += xor_swz<4>(ss[r]); ss[r] += xor_swz<8>(ss[r]); ss[r] += xor_swz<16>(ss[r]);
        ss[r] = __builtin_amdgcn_rsqf(ss[r] * (1.f / 128.f) + EPS) * A.oscale; }
      const unsigned obs = (unsigned)((qrow0 + wid * 32) * DM + h * 128) * 2u;
      const unsigned ooff = (unsigned)(4 * hi * DM + r32) * 2u;
#pragma unroll
      for (int d0 = 0; d0 < 4; ++d0) { const float g = A.subln_g[d0 * 32 + r32];
#pragma unroll
        for (int r = 0; r < 16; ++r) { const unsigned w = cvt_pk_bf16(o[d0][r] * ss[r] * g, 0.f);
          __builtin_amdgcn_raw_buffer_store_b16((unsigned short)(w & 0xffffu), rO, (int)ooff, (int)(obs + (unsigned)((((r & 3) + 8 * (r >> 2)) * DM + d0 * 32) * 2)), 0); }
        asm volatile("" ::: "memory"); }
    }
  }
#undef KROWB
#undef DMA_K
#undef DMA_V1
#undef DMA_V2
#undef VS
#undef KRD
#undef VRD
#undef VFR
#undef PAF
#undef RESC
}
}

#define XB_TMO      128
#define XB_XCNT(j)  (256  + 64 * (j))
#define XB_XSUB(j)  (1280 + 64 * (j))
#define XB_XGEN(j)  (2304 + 64 * (j))
#define XB_TOP      3328
#define XB_TOPGEN   3392
#define XCD_BAR_WORDS 3456
#define XB_SPIN_CAP (1u << 18)

__device__ __forceinline__ unsigned xb_ld(unsigned* p)              { return __hip_atomic_load(p, __ATOMIC_RELAXED, __HIP_MEMORY_SCOPE_AGENT); }
__device__ __forceinline__ unsigned xb_add(unsigned* p, unsigned v) { return __hip_atomic_fetch_add(p, v, __ATOMIC_RELAXED, __HIP_MEMORY_SCOPE_AGENT); }
__device__ __forceinline__ unsigned xb_xcc_id() { return (unsigned)__builtin_amdgcn_s_getreg((3 << 11) | 20) & 0xFu; }
#define XB_SPIN(cond, bar) do { unsigned _sp = 0; while (cond) { __builtin_amdgcn_s_sleep(1); \
    if ((++_sp & 255u) == 0u) { if (xb_ld(&(bar)[XB_TMO])) break; if (_sp > XB_SPIN_CAP) { atomicAdd(&(bar)[XB_TMO], 1u); break; } } } } while (0)

struct XcdBarrier {
    unsigned* bar; unsigned x;
    volatile LAS unsigned* st;
};
__device__ __forceinline__ XcdBarrier xcd_barrier_post(unsigned* bar, volatile LAS unsigned* st, int wave_s_) {
    XcdBarrier b; b.bar = bar; b.x = xb_xcc_id(); b.st = st;
    if (wave_s_ == 0 && lane_id() == 0) (void)xb_add(&bar[XB_XCNT(b.x)], 1u);
    return b;
}
__device__ __forceinline__ void xcd_barrier_complete(unsigned* bar, unsigned x, unsigned& nloc, unsigned& nx) {
    const unsigned G = gridDim.x * gridDim.y * gridDim.z;
    unsigned sum, cnt, mine, sp = 0u;
    for (;;) {
        sum = 0u; cnt = 0u; mine = 0u;
#pragma unroll
        for (unsigned j = 0; j < 16; ++j) { const unsigned c = xb_ld(&bar[XB_XCNT(j)]); sum += c; cnt += (c > 0u) ? 1u : 0u; mine = (j == x) ? c : mine; }
        if (sum == G) break;
        __builtin_amdgcn_s_sleep(1);
        if ((++sp & 255u) == 0u) { if (xb_ld(&bar[XB_TMO])) break; if (sp > XB_SPIN_CAP) { atomicAdd(&bar[XB_TMO], 1u); break; } }
    }
    nloc = mine > 0u ? mine : 1u; nx = cnt > 0u ? cnt : 1u;
}
__device__ __forceinline__ void xcd_barrier(const XcdBarrier& b, int wave_s_) {
    asm volatile("s_waitcnt vmcnt(0)" ::: "memory");
    __syncthreads();
    if (wave_s_ == 0 && lane_id() == 0) {
        unsigned* bar = b.bar;
        __builtin_amdgcn_s_waitcnt(0);
        unsigned nloc = b.st[0], nx = b.st[1];
        if (nloc == 0u) { xcd_barrier_complete(bar, b.x, nloc, nx); b.st[0] = nloc; b.st[1] = nx; }
        const unsigned old = xb_add(&bar[XB_XSUB(b.x)], 1u);
        const unsigned gen = old / nloc;
        if (old + 1u == (gen + 1u) * nloc) {
            __builtin_amdgcn_fence(__ATOMIC_RELEASE, "agent");
            asm volatile("s_waitcnt vmcnt(0)" ::: "memory");
            const unsigned og = xb_add(&bar[XB_TOP], 1u);
            const unsigned tg = og / nx;
            if (og + 1u == (tg + 1u) * nx) xb_add(&bar[XB_TOPGEN], 1u);
            else XB_SPIN(xb_ld(&bar[XB_TOPGEN]) == tg, bar);
            __builtin_amdgcn_fence(__ATOMIC_ACQUIRE, "agent");
            xb_add(&bar[XB_XGEN(b.x)], 1u);
            asm volatile("s_waitcnt vmcnt(0)" ::: "memory");
        } else {
            XB_SPIN(xb_ld(&bar[XB_XGEN(b.x)]) == gen, bar);
            __builtin_amdgcn_fence(__ATOMIC_ACQUIRE, "agent");
            asm volatile("s_waitcnt vmcnt(0)" ::: "memory");
        }
    }
    __syncthreads();
}

struct KArgs {
    const float* in[25];
    float* out; unsigned char* ws;
    int ph_lo, ph_hi;
};
enum { I_X = 0, I_C, I_CTX, I_CCTX, I_MODW, I_MODB, I_NMIX, I_NFFN, I_WQKV, I_WO, I_LAM, I_SUBLN, I_WIN, I_CONVW, I_CONVB, I_GATEW, I_GATEB, I_APARAM, I_WOUT,
       I_FGU, I_FDN, I_ROUTER, I_MGU, I_MDN, I_FNORM };

__device__ __forceinline__ int p0_dest_row(int n, int mode, int F) {
    if (mode == 2) { const int nn = n >= F ? 1 : 0, j = n - nn * F;
        return 256 * (j >> 7) + 128 * ((j >> 2) & 1) + 32 * ((j >> 5) & 3) + 16 * nn + 4 * ((j >> 3) & 3) + (j & 3); }
    if (mode == 1 || (mode == 3 && n >= 2048)) { const int s = n & 31; return (n & ~31) + 16 * ((s >> 2) & 1) + 4 * (s >> 3) + (s & 3); }
    return n;
}
__device__ __forceinline__ void p0_transpose_item(const float* W, int K, int N, bf16_t* WT, int mode, int F, LAS float* scr, int item, int lane, float wscale) {
    const int nblk = N / 32, kb = item / nblk, nb = item % nblk, k0 = 64 * kb, n0 = 32 * nb;
    float tmp[32];
#pragma unroll
    for (int i = 0; i < 32; ++i) { const int kk = 2 * i + (lane >> 5); tmp[i] = W[(size_t)(k0 + kk) * N + n0 + (lane & 31)]; }
#pragma unroll
    for (int i = 0; i < 32; ++i) { const int kk = 2 * i + (lane >> 5); scr[kk * 33 + (lane & 31)] = tmp[i]; }
    LDS_WAIT(); asm volatile("" ::: "memory");
    const int c = lane & 7;
#pragma unroll
    for (int j = 0; j < 4; ++j) { const int n = (lane >> 3) + 8 * j; const LAS float* s = scr + (8 * c) * 33 + n;
        u32x4 o; o.x = cvt_pk_bf16(s[0 * 33] * wscale, s[1 * 33] * wscale); o.y = cvt_pk_bf16(s[2 * 33] * wscale, s[3 * 33] * wscale); o.z = cvt_pk_bf16(s[4 * 33] * wscale, s[5 * 33] * wscale); o.w = cvt_pk_bf16(s[6 * 33] * wscale, s[7 * 33] * wscale);
        *(u32x4*)(WT + (size_t)p0_dest_row(n0 + n, mode, F) * K + k0 + 8 * c) = o; }
    LDS_WAIT(); asm volatile("" ::: "memory");
}
__device__ __forceinline__ void p0_transpose_item_f8(const float* W, int K, int N, unsigned char* WT, int mode, int F, LAS float* scr, int item, int lane) {
    const int nblk = N / 32, kb = item / nblk, nb = item % nblk, k0 = 64 * kb, n0 = 32 * nb;
    float tmp[32];
#pragma unroll
    for (int i = 0; i < 32; ++i) { const int kk = 2 * i + (lane >> 5); tmp[i] = W[(size_t)(k0 + kk) * N + n0 + (lane & 31)]; }
#pragma unroll
    for (int i = 0; i < 32; ++i) { const int kk = 2 * i + (lane >> 5); scr[kk * 33 + (lane & 31)] = tmp[i]; }
    LDS_WAIT(); asm volatile("" ::: "memory");
    const int n = lane >> 1, kh = (lane & 1) * 32; const LAS float* s = scr + kh * 33 + n;
    const float wsc = W8_SCALE * (mode == 2 ? ((n0 + n) < F ? -1.4426950408889634f : -0.6931471805599453f) : 1.f);
    u32x4 o0, o1;
    o0.x = cvt4_fp8(s[0 * 33] * wsc, s[1 * 33] * wsc, s[2 * 33] * wsc, s[3 * 33] * wsc);     o0.y = cvt4_fp8(s[4 * 33] * wsc, s[5 * 33] * wsc, s[6 * 33] * wsc, s[7 * 33] * wsc);
    o0.z = cvt4_fp8(s[8 * 33] * wsc, s[9 * 33] * wsc, s[10 * 33] * wsc, s[11 * 33] * wsc);   o0.w = cvt4_fp8(s[12 * 33] * wsc, s[13 * 33] * wsc, s[14 * 33] * wsc, s[15 * 33] * wsc);
    o1.x = cvt4_fp8(s[16 * 33] * wsc, s[17 * 33] * wsc, s[18 * 33] * wsc, s[19 * 33] * wsc); o1.y = cvt4_fp8(s[20 * 33] * wsc, s[21 * 33] * wsc, s[22 * 33] * wsc, s[23 * 33] * wsc);
    o1.z = cvt4_fp8(s[24 * 33] * wsc, s[25 * 33] * wsc, s[26 * 33] * wsc, s[27 * 33] * wsc); o1.w = cvt4_fp8(s[28 * 33] * wsc, s[29 * 33] * wsc, s[30 * 33] * wsc, s[31 * 33] * wsc);
    unsigned char* d = WT + (size_t)p0_dest_row(n0 + n, mode, F) * K + k0 + kh;
    *(u32x4*)d = o0; *(u32x4*)(d + 16) = o1;
    LDS_WAIT(); asm volatile("" ::: "memory");
}
__device__ __forceinline__ void p0_prologue(const KArgs& a, LAS unsigned char* lds, int vcu, int G, int wave_s_) {
    const int tid = opaque_tid(wave_s_), lane = tid & 63, wave = __builtin_amdgcn_readfirstlane(tid >> 6);
    unsigned char* ws = a.ws;
    LAS float* sl = (LAS float*)(lds + 73728);
    LAS float* red = (LAS float*)(lds + 98304);
    for (int i = tid; i < 5 * 1024; i += 512) { const float x = i < 4096 ? a.in[I_C][i] : a.in[I_CCTX][i - 4096]; sl[i] = x * sigmoid_f(x); }
    __syncthreads();
    float* MOD = (float*)(ws + WS_MOD);
    for (int u = vcu; u < DEPTH * 96; u += G) {
        const int layer = u / 96, n0 = (u % 96) * 64;
        const float* W = a.in[I_MODW] + (size_t)layer * 1024 * 6144 + n0 + lane;
        float acc[5] = {0.f, 0.f, 0.f, 0.f, 0.f};
        const int kbeg = wave * 128;
#pragma unroll 8
        for (int k = 0; k < 128; ++k) { const float w = W[(size_t)(kbeg + k) * 6144];
#pragma unroll
            for (int v = 0; v < 5; ++v) acc[v] += sl[v * 1024 + kbeg + k] * w; }
#pragma unroll
        for (int v = 0; v < 5; ++v) red[(wave * 5 + v) * 64 + lane] = acc[v];
        __syncthreads();
        if (wave < 5) { float s = a.in[I_MODB][layer * 6144 + n0 + lane];
#pragma unroll
            for (int w = 0; w < 8; ++w) s += red[(w * 5 + wave) * 64 + lane];
            MOD[(layer * 5 + wave) * 6144 + n0 + lane] = s; }
        __syncthreads();
    }
    if (vcu == 0) { float* rope = (float*)(ws + WS_ROPE);
        for (int i = tid; i < 2048; i += 512) { const int pos = i >> 4, f = i & 15; const float inv = exp2f(-(float)f * (13.287712379549449f / 16.f)); const float ang = (float)pos * inv;
            rope[i] = __cosf(ang); rope[2048 + i] = __sinf(ang); } }
    LAS float* scr = (LAS float*)(lds + wave * 8448);
    const int gw = vcu * 8 + wave, NGW = G * 8;
    constexpr int N_QKV = 2 * 16 * 96, N_WO = 2 * 16 * 32, N_FGU = 2 * 16 * 176, N_FDN = 2 * 44 * 32, N_WIN = 2 * 16 * 64, N_WOUT = 2 * 16 * 32, N_GW = 64 * 8,
                  N_MGU = 16 * 16 * 224, N_MDN = 16 * 56 * 32;
    constexpr int NITEMS = N_QKV + N_WO + N_FGU + N_FDN + N_WIN + N_WOUT + N_GW + N_MGU + N_MDN;
    for (int it = gw; it < NITEMS; it += NGW) {
        int r = it; const float* src; bf16_t* dst; int K, N, mode = 0, F = 0, per, mat; bool f8 = false; float wscale = 1.f;
        if (r < N_QKV) { per = 16 * 96; mat = r / per; r -= mat * per; K = 1024; N = 3072; mode = 3; src = a.in[I_WQKV] + (size_t)mat * K * N; dst = (bf16_t*)(ws + WS_WQKV) + (size_t)mat * K * N; }
        else if ((r -= N_QKV) < N_WO) { per = 16 * 32; mat = r / per; r -= mat * per; K = 1024; N = 1024; src = a.in[I_WO] + (size_t)mat * K * N; dst = (bf16_t*)(ws + WS_WO) + (size_t)mat * K * N; }
        else if ((r -= N_WO) < N_FGU) { per = 16 * 176; mat = r / per; r -= mat * per; K = 1024; N = 2 * FF; mode = 2; F = FF; f8 = true; src = a.in[I_FGU] + (size_t)mat * K * N; dst = (bf16_t*)(ws + WS_WGU + (size_t)mat * K * N); }
        else if ((r -= N_FGU) < N_FDN) { per = 44 * 32; mat = r / per; r -= mat * per; K = FF; N = 1024; f8 = true; src = a.in[I_FDN] + (size_t)mat * K * N; dst = (bf16_t*)(ws + WS_WDN + (size_t)mat * K * N); }
        else if ((r -= N_FDN) < N_WIN) { per = 16 * 64; mat = r / per; r -= mat * per; K = 1024; N = 2048; mode = 1; src = a.in[I_WIN] + (size_t)mat * K * N; dst = (bf16_t*)(ws + WS_WIN) + (size_t)mat * K * N; }
        else if ((r -= N_WIN) < N_WOUT) { per = 16 * 32; mat = r / per; r -= mat * per; K = 1024; N = 1024; src = a.in[I_WOUT] + (size_t)mat * K * N; dst = (bf16_t*)(ws + WS_WOUT) + (size_t)mat * K * N; }
        else if ((r -= N_WOUT) < N_GW) { per = 8; mat = r / per; r -= mat * per; K = 128; N = 128; wscale = -1.4426950408889634f; src = a.in[I_GATEW] + (size_t)mat * K * N; dst = (bf16_t*)(ws + WS_GW) + (size_t)mat * K * N; }
        else if ((r -= N_GW) < N_MGU) { per = 16 * 224; mat = r / per; r -= mat * per; K = 1024; N = 2 * FE; mode = 2; F = FE; f8 = true; src = a.in[I_MGU] + (size_t)mat * K * N; dst = (bf16_t*)(ws + WS_MGU + (size_t)mat * K * N); }
        else { r -= N_MGU; per = 56 * 32; mat = r / per; r -= mat * per; K = FE; N = 1024; mode = 1; f8 = true; src = a.in[I_MDN] + (size_t)mat * K * N; dst = (bf16_t*)(ws + WS_MDN + (size_t)mat * K * N); }
        if (f8) p0_transpose_item_f8(src, K, N, (unsigned char*)dst, mode, F, scr, r, lane);
        else p0_transpose_item(src, K, N, dst, mode, F, scr, r, lane, wscale);
    }
}

template <bool SRC_IN, bool COMBINE, bool ROUTER, bool FINAL, bool F8OUT = false>
__device__ __forceinline__ void norm_phase(const KArgs& a, LAS unsigned char* lds, int G, const float* gain, const float* modl  , int sh_off, int sc_off,
                                           const float* g2prev  , const float* router_w, int nrows, int wave_s_) {
    const int tid = opaque_tid(wave_s_), lane = tid & 63, wave = __builtin_amdgcn_readfirstlane(tid >> 6), bx = blockIdx.x;
    unsigned char* ws = a.ws;
    bf16_t* XS = (bf16_t*)(ws + WS_XS); bf16_t* H = (bf16_t*)(ws + WS_H); const bf16_t* YP = (const bf16_t*)(ws + WS_YP);
    i32x2* TOKI = (i32x2*)(ws + WS_TOKI); f32x2* TOKW = (f32x2*)(ws + WS_TOKW);
    const int rpw = (nrows + G - 1) / G, r0 = bx * rpw, r1 = (r0 + rpw) < nrows ? (r0 + rpw) : nrows;
    LAS float* RW = (LAS float*)lds;
    LAS int* lcnt = (LAS int*)(lds + 32768);
    int cnt[8] = {0, 0, 0, 0, 0, 0, 0, 0};
    if (ROUTER) {
        for (int i = tid; i < 8192; i += 512) RW[(i & 7) * 1024 + (i >> 3)] = router_w[i];
        if (tid < 8) lcnt[tid] = 0;
        __syncthreads();
    }
    struct NRow { f32x4 xf[4]; u32x2 xw[4]; u32x2 y1[4], y2[4]; f32x2 ww; };
    auto issue = [&](int row, i32x2 pp, NRow& R) {
        if (SRC_IN) { const float* xr = row < RL ? a.in[I_X] + (size_t)row * DM : a.in[I_CTX] + (size_t)(row - RL) * DM;
#pragma unroll
            for (int j = 0; j < 4; ++j) R.xf[j] = *(const f32x4*)(xr + 4 * lane + 256 * j); }
        else { const bf16_t* xr = XS + (size_t)row * DM;
#pragma unroll
            for (int j = 0; j < 4; ++j) R.xw[j] = *(const u32x2*)(xr + 4 * lane + 256 * j); }
        if (COMBINE) { R.ww = TOKW[row];
            const bf16_t* y1 = YP + (size_t)pp.x * DM; const bf16_t* y2 = YP + (size_t)pp.y * DM;
#pragma unroll
            for (int j = 0; j < 4; ++j) { R.y1[j] = *(const u32x2*)(y1 + 4 * lane + 256 * j); R.y2[j] = *(const u32x2*)(y2 + 4 * lane + 256 * j); } }
    };
    f32x4 gv[4], scv[4], shv[4], g2v[4]; int mi_cur = -1;
#pragma unroll
    for (int j = 0; j < 4; ++j) gv[j] = *(const f32x4*)(gain + 4 * lane + 256 * j);
    constexpr int NB = (SRC_IN || COMBINE || ROUTER) ? 2 : 4;
    for (int rowb = r0 + wave; rowb < r1; rowb += 8 * NB) {
      NRow R[NB];
      { i32x2 pp[NB];
#pragma unroll
        for (int k = 0; k < NB; ++k) { pp[k] = (i32x2){0, 0}; if (COMBINE && rowb + 8 * k < r1) pp[k] = TOKI[rowb + 8 * k]; }
#pragma unroll
        for (int k = 0; k < NB; ++k) if (rowb + 8 * k < r1) issue(rowb + 8 * k, pp[k], R[k]);
        asm volatile("" ::: "memory"); __builtin_amdgcn_sched_barrier(0); }
#pragma unroll
      for (int k = 0; k < NB; ++k) {
        const int row = rowb + 8 * k; if (row >= r1) break;
        const NRow& cur = R[k];
        const bool lat = row < RL; const int mi = lat ? (row >> 13) : 4;
        f32x4 v[4];
        if (SRC_IN) {
#pragma unroll
            for (int j = 0; j < 4; ++j) v[j] = cur.xf[j]; }
        else {
#pragma unroll
            for (int j = 0; j < 4; ++j) { const u32x2 w = cur.xw[j]; v[j] = (f32x4){bf_lo(w.x), bf_hi(w.x), bf_lo(w.y), bf_hi(w.y)}; } }
        if (mi != mi_cur) {
            mi_cur = mi;
            if (!FINAL) { const float* ml = modl + mi * 6144;
#pragma unroll
                for (int j = 0; j < 4; ++j) { scv[j] = *(const f32x4*)(ml + sc_off + 4 * lane + 256 * j) + 1.f; shv[j] = *(const f32x4*)(ml + sh_off + 4 * lane + 256 * j); } }
            if (COMBINE) { const float* g2 = g2prev + mi * 6144;
#pragma unroll
                for (int j = 0; j < 4; ++j) g2v[j] = *(const f32x4*)(g2 + 4 * lane + 256 * j); }
        }
        if (COMBINE) {
            const f32x2 ww = cur.ww;
#pragma unroll
            for (int j = 0; j < 4; ++j) { const u32x2 a1 = cur.y1[j], a2 = cur.y2[j]; const f32x4 gg = g2v[j];
                v[j].x += gg.x * (ww.x * bf_lo(a1.x) + ww.y * bf_lo(a2.x)); v[j].y += gg.y * (ww.x * bf_hi(a1.x) + ww.y * bf_hi(a2.x));
                v[j].z += gg.z * (ww.x * bf_lo(a1.y) + ww.y * bf_lo(a2.y)); v[j].w += gg.w * (ww.x * bf_hi(a1.y) + ww.y * bf_hi(a2.y)); }
        }
        if ((SRC_IN || COMBINE) && !FINAL) {
#pragma unroll
            for (int j = 0; j < 4; ++j) { u32x2 w; w.x = cvt_pk_bf16(v[j].x, v[j].y); w.y = cvt_pk_bf16(v[j].z, v[j].w); *(u32x2*)(XS + (size_t)row * DM + 4 * lane + 256 * j) = w; }
        }
        float ss = 0.f;
#pragma unroll
        for (int j = 0; j < 4; ++j) ss += (v[j].x * v[j].x + v[j].y * v[j].y) + (v[j].z * v[j].z + v[j].w * v[j].w);
        const float rs = __builtin_amdgcn_rsqf(wave_sum(ss) * (1.f / DM) + EPS);
        if (FINAL) {
#pragma unroll
            for (int j = 0; j < 4; ++j) *(f32x4*)(a.out + (size_t)row * DM + 4 * lane + 256 * j) = v[j] * rs * gv[j];
        } else {
            float lg[8] = {0.f, 0.f, 0.f, 0.f, 0.f, 0.f, 0.f, 0.f};
#pragma unroll
            for (int j = 0; j < 4; ++j) {
                const f32x4 o = v[j] * rs * gv[j] * scv[j] + shv[j];
                if (ROUTER || F8OUT) *(unsigned*)((unsigned char*)H + (size_t)row * DM + 4 * lane + 256 * j) = cvt4_fp8(o.x, o.y, o.z, o.w);
                else { u32x2 w; w.x = cvt_pk_bf16(o.x, o.y); w.y = cvt_pk_bf16(o.z, o.w); *(u32x2*)(H + (size_t)row * DM + 4 * lane + 256 * j) = w; }
                if (ROUTER) {
#pragma unroll
                    for (int e = 0; e < 8; ++e) { const f32x4 rw = *(const LAS f32x4*)(RW + e * 1024 + 4 * lane + 256 * j); lg[e] += (o.x * rw.x + o.y * rw.y) + (o.z * rw.z + o.w * rw.w); } }
            }
            if (ROUTER) {
#pragma unroll
                for (int e = 0; e < 8; ++e) lg[e] = wave_sum(lg[e]);
                int e1 = 0; float l1 = lg[0];
#pragma unroll
                for (int e = 1; e < 8; ++e) if (lg[e] > l1) { l1 = lg[e]; e1 = e; }
                int e2 = -1; float l2 = -3.0e38f;
#pragma unroll
                for (int e = 0; e < 8; ++e) if (e != e1 && lg[e] > l2) { l2 = lg[e]; e2 = e; }
                e1 = __builtin_amdgcn_readfirstlane(e1); e2 = __builtin_amdgcn_readfirstlane(e2);
                const float w1 = fast_rcp(1.f + __expf(l2 - l1));
                if (lane == 0) { ((i32x2*)(ws + WS_TOKE))[row] = (i32x2){e1, e2}; TOKW[row] = (f32x2){w1, 1.f - w1}; }
#pragma unroll
                for (int e = 0; e < 8; ++e) cnt[e] += (e == e1 || e == e2) ? 1 : 0;
            }
        }
      }
    }
    if (ROUTER) {
        if (lane == 0) {
#pragma unroll
            for (int e = 0; e < 8; ++e) atomicAdd((int*)(lcnt + e), cnt[e]); }
        __syncthreads();
        if (tid < 8) ((int*)(ws + WS_CNT))[bx * 8 + tid] = lcnt[tid];
    }
}

__device__ __forceinline__ void moe_place_phase(const KArgs& a, LAS unsigned char* lds, int G, int nrows, int wave_s_) {
    const int tid = opaque_tid(wave_s_), lane = tid & 63, wave = __builtin_amdgcn_readfirstlane(tid >> 6), bx = blockIdx.x;
    unsigned char* ws = a.ws;
    const int* CNT = (const int*)(ws + WS_CNT); int* SEG = (int*)(ws + WS_SEG);
    i32x2* TOKI = (i32x2*)(ws + WS_TOKI); const bf16_t* H = (const bf16_t*)(ws + WS_H); bf16_t* FP = (bf16_t*)(ws + WS_FP);
    const int rpw = (nrows + G - 1) / G, r0 = bx * rpw, r1 = (r0 + rpw) < nrows ? (r0 + rpw) : nrows, nr = r1 > r0 ? r1 - r0 : 0;
    LAS int* tot = (LAS int*)lds; LAS int* pre = tot + 8; LAS int* base = tot + 16; LAS i32x2* plist = (LAS i32x2*)(lds + 256);
    { int t = 0, p = 0;
        for (int g = lane; g < G; g += 64) { const int c = CNT[g * 8 + wave]; t += c; p += (g < bx) ? c : 0; }
        t = wave_sum_i(t); p = wave_sum_i(p);
        if (lane == 0) { tot[wave] = t; pre[wave] = p; } }
    for (int i = tid; i < nr; i += 512) plist[i] = ((const i32x2*)(ws + WS_TOKE))[r0 + i];
    __syncthreads();
    if (wave == 0) {
        int b[8]; int off = 0;
#pragma unroll
        for (int e = 0; e < 8; ++e) { b[e] = off + pre[e]; if (bx == 0 && lane == 0) SEG[e] = off; off += (tot[e] + 255) & ~255; }
        if (bx == 0 && lane == 0) SEG[8] = off;
        const unsigned long long lt = (1ull << lane) - 1ull;
        for (int c0 = 0; c0 < nr; c0 += 64) {
            const int i = c0 + lane; const bool valid = i < nr; const i32x2 ee = valid ? plist[i] : (i32x2){-1, -1};
            int p1 = 0, p2 = 0;
#pragma unroll
            for (int e = 0; e < 8; ++e) { const unsigned long long mm = __ballot(valid && (ee.x == e || ee.y == e));
                const int before = b[e] + __popcll(mm & lt);
                if (ee.x == e) p1 = before; if (ee.y == e) p2 = before;
                b[e] += __popcll(mm); }
            if (valid) plist[i] = (i32x2){p1, p2};
        }
    }
    __syncthreads();
    for (int i = tid; i < nr; i += 512) TOKI[r0 + i] = plist[i];
    for (int i = wave; i < nr; i += 8) { const i32x2 pp = plist[i];
        const u32x4 x0 = ((const u32x4*)((const unsigned char*)H + (size_t)(r0 + i) * DM))[lane];
        ((u32x4*)((unsigned char*)FP + (size_t)pp.x * DM))[lane] = x0; ((u32x4*)((unsigned char*)FP + (size_t)pp.y * DM))[lane] = x0; }
}

typedef __amdgpu_buffer_rsrc_t rsrc_t;
__device__ __forceinline__ rsrc_t mk_rsrc_n(const void* p, unsigned nbytes) { return __builtin_amdgcn_make_buffer_rsrc(const_cast<void*>(p), 0, (int)nbytes, 0x00020000); }
constexpr int LCH = 128, NLC = SEQ / LCH  , NCC = CTXL / LCH  , NCHUNK = NBATCH * (NLC + NCC)  , CTX_C0 = NBATCH * NLC  ;
template <bool FULL>
__device__ __forceinline__ void lru_chunk_phase(const KArgs& a, LAS unsigned char* lds, int vcu, int G, int j  , bool skip_ctx_out, int wave_s_) {
    const int tid = opaque_tid(wave_s_), lane = tid & 63, wave = __builtin_amdgcn_readfirstlane(tid >> 6), c = lane & 15, q = lane >> 4;
    unsigned char* ws = a.ws;
    const bf16_t* P = (const bf16_t*)(ws + WS_P); const bf16_t* GW = (const bf16_t*)(ws + WS_GW);
    LAS unsigned char* U = lds;
    LAS unsigned char* GT = lds + 32768;
    LAS f32x2* XQ = (LAS f32x2*)(lds + 135168) + wave * 64;
    LAS float* HFL = (LAS float*)(lds + 65536);
    const rsrc_t rTot = mk_rsrc_n(ws + WS_TOT, 2u * NCHUNK * 1024u * 8u), rPre = mk_rsrc_n(ws + WS_PRE, 2u * NCHUNK * 1024u * 4u);
    const int cgp = tid & 15, sg = tid >> 4;
    int cur_blk = -1;
    bf16x8 Wf[2][2][4];
    float br[2], bi[2], Lc2[2];
    for (int u = vcu; u < NCHUNK * 8; u += G) {
        const int cidx = u >> 3, blk = u & 7;
        const bool is_ctx = cidx >= CTX_C0;
        if (FULL && skip_ctx_out && is_ctx) continue;
        const int b = is_ctx ? (cidx - CTX_C0) >> 1 : cidx >> 6, kc = is_ctx ? (cidx - CTX_C0) & 1 : cidx & 63, t0 = kc * LCH, rowbase = is_ctx ? RL + b * CTXL : b * SEQ, seglen = is_ctx ? CTXL : SEQ;
        const int ch = blk * 128 + wave * 16 + c;
        if (blk != cur_blk) {
            cur_blk = blk;
#pragma unroll
            for (int d = 0; d < 2; ++d) {
#pragma unroll
                for (int g = 0; g < 2; ++g) { const bf16_t* gp = GW + ((size_t)(((j * 2 + d) * 2 + g) * 8 + blk) * 128 + wave * 16 + c) * 128 + q * 8;
#pragma unroll
                    for (int ks = 0; ks < 4; ++ks) Wf[d][g][ks] = *(const bf16x8*)(gp + ks * 32); }
                br[d] = -1.4426950408889634f * a.in[I_GATEB][((j * 2 + d) * 2 + 0) * DM + ch]; bi[d] = -1.4426950408889634f * a.in[I_GATEB][((j * 2 + d) * 2 + 1) * DM + ch];
                const float ap = a.in[I_APARAM][(j * 2 + d) * DM + ch];
                Lc2[d] = 8.f * 1.4426950408889634f * (fminf(ap, 0.f) - log1pf(__expf(-fabsf(ap))));
            }
        }
        const rsrc_t rP = mk_rsrc_n(P + (size_t)rowbase * DM, (unsigned)seglen * DM * 2u);
        u32x4 pr[7];
#pragma unroll
        for (int r = 0; r < 7; ++r) pr[r] = __builtin_amdgcn_raw_buffer_load_b128(rP, (int)((unsigned)((t0 + 4 * sg - 2 + r) * DM + blk * 128 + cgp * 8) * 2u), 0, 0);
        float hF = 0.f, hB = 0.f;
        if (FULL) {
            const rsrc_t rG = mk_rsrc_n(ws + WS_GATE, 0x7fffffffu);
            u32x4 gt[4];
#pragma unroll
            for (int k = 0; k < 4; ++k) { const int idx = tid + 512 * k, row = idx >> 4, chk = idx & 15;
                gt[k] = __builtin_amdgcn_raw_buffer_load_b128(rG, (int)((unsigned)(row * DM + blk * 128 + chk * 8) * 2u), (int)((unsigned)(rowbase + t0) * (DM * 2u)), 0); }
            hF = __uint_as_float(__builtin_amdgcn_raw_buffer_load_b32(rPre, (int)((unsigned)ch * 4u), (int)((0 * NCHUNK + cidx) * 4096), 0));
            hB = __uint_as_float(__builtin_amdgcn_raw_buffer_load_b32(rPre, (int)((unsigned)ch * 4u), (int)((1 * NCHUNK + cidx) * 4096), 0));
#pragma unroll
            for (int k = 0; k < 4; ++k) { const int idx = tid + 512 * k, row = idx >> 4, chk = idx & 15; *(LAS u32x4*)(GT + row * 256 + ((chk ^ (row & 15)) << 4)) = gt[k]; }
        }
        float cw[4][8], cb[8];
        {
            const float* wp = a.in[I_CONVW] + (size_t)j * 4 * DM + blk * 128 + cgp * 8;
#pragma unroll
            for (int t = 0; t < 4; ++t) { const f32x4 w0 = *(const f32x4*)(wp + t * DM), w1 = *(const f32x4*)(wp + t * DM + 4);
                cw[t][0] = w0.x; cw[t][1] = w0.y; cw[t][2] = w0.z; cw[t][3] = w0.w; cw[t][4] = w1.x; cw[t][5] = w1.y; cw[t][6] = w1.z; cw[t][7] = w1.w; }
            const float* bp = a.in[I_CONVB] + (size_t)j * DM + blk * 128 + cgp * 8; const f32x4 b0 = *(const f32x4*)bp, b1 = *(const f32x4*)(bp + 4);
            cb[0] = b0.x; cb[1] = b0.y; cb[2] = b0.z; cb[3] = b0.w; cb[4] = b1.x; cb[5] = b1.y; cb[6] = b1.z; cb[7] = b1.w;
        }
#pragma unroll
        for (int k = 0; k < 4; ++k) {
            float acc[8];
#pragma unroll
            for (int e = 0; e < 8; ++e) acc[e] = cb[e];
#pragma unroll
            for (int tap = 0; tap < 4; ++tap) { const u32x4 pv = pr[k + tap];
                acc[0] += cw[tap][0] * bf_lo(pv.x); acc[1] += cw[tap][1] * bf_hi(pv.x); acc[2] += cw[tap][2] * bf_lo(pv.y); acc[3] += cw[tap][3] * bf_hi(pv.y);
                acc[4] += cw[tap][4] * bf_lo(pv.z); acc[5] += cw[tap][5] * bf_hi(pv.z); acc[6] += cw[tap][6] * bf_lo(pv.w); acc[7] += cw[tap][7] * bf_hi(pv.w); }
            u32x4 w; w.x = cvt_pk_bf16(acc[0], acc[1]); w.y = cvt_pk_bf16(acc[2], acc[3]); w.z = cvt_pk_bf16(acc[4], acc[5]); w.w = cvt_pk_bf16(acc[6], acc[7]);
            const int tt = 4 * sg + k;
            *(LAS u32x4*)(U + tt * 256 + ((cgp ^ (tt & 15)) << 4)) = w;
        }
        __syncthreads();
#define LRU_SUB(d, ms) \
            f32x4 aR = (f32x4){br[d], br[d], br[d], br[d]}, aI = (f32x4){bi[d], bi[d], bi[d], bi[d]};     \
            { const int m = 16 * (ms) + c; \
              _Pragma("unroll") for (int ks = 0; ks < 4; ++ks) { const bf16x8 af = *(const LAS bf16x8*)(U + m * 256 + (((ks * 4 + q) ^ c) << 4)); \
                aR = __builtin_amdgcn_mfma_f32_16x16x32_bf16(af, Wf[d][0][ks], aR, 0, 0, 0); aI = __builtin_amdgcn_mfma_f32_16x16x32_bf16(af, Wf[d][1][ks], aI, 0, 0, 0); } } \
            float av[4], bv[4]; \
            _Pragma("unroll") for (int i = 0; i < 4; i += 2) {                                          \
                const int chb = wave * 16 + c; const int t0_ = 16 * (ms) + 4 * q + i, t1_ = t0_ + 1; \
                const f32x2 uv = {bf2f(*(const LAS bf16_t*)(U + t0_ * 256 + (((chb >> 3) ^ (t0_ & 15)) << 4) + (chb & 7) * 2)), bf2f(*(const LAS bf16_t*)(U + t1_ * 256 + (((chb >> 3) ^ (t1_ & 15)) << 4) + (chb & 7) * 2))}; \
                const f32x2 eR = (f32x2){fast_exp2(aR[i]), fast_exp2(aR[i + 1])} + 1.f, eI = (f32x2){fast_exp2(aI[i]), fast_exp2(aI[i + 1])} + 1.f; \
                const f32x2 rr = {fast_rcp(eR.x), fast_rcp(eR.y)}, ig = {fast_rcp(eI.x), fast_rcp(eI.y)}; \
                const f32x2 la = rr * Lc2[d]; const f32x2 at = {fast_exp2(la.x), fast_exp2(la.y)}; \
                const f32x2 om = (f32x2){1.f, 1.f} - at * at; \
                const f32x2 sq = {__builtin_sqrtf(fmaxf(om.x, 0.f)), __builtin_sqrtf(fmaxf(om.y, 0.f))}; \
                const f32x2 b2 = sq * (ig * uv); \
                av[i] = at.x; av[i + 1] = at.y; bv[i] = b2.x; bv[i + 1] = b2.y; }
        float TA0 = 1.f, TB0 = 0.f, TA1 = 1.f, TB1 = 0.f;
#pragma unroll 2
        for (int ms = 0; ms < LCH / 16; ++ms) {
            LRU_SUB(0, ms)
            float pa[4], pb[4]; float A_ = 1.f, B_ = 0.f;
#pragma unroll
            for (int i = 0; i < 4; ++i) { B_ = av[i] * B_ + bv[i]; A_ = A_ * av[i]; pa[i] = A_; pb[i] = B_; }
            float ea = 1.f, eb = 0.f, sa = 1.f, sb = 0.f;
            XQ[lane] = (f32x2){A_, B_};
#pragma unroll
            for (int qq = 0; qq < 4; ++qq) { const f32x2 tq = XQ[c + 16 * qq]; const float ta = tq.x, tb = tq.y;
                if (qq < q) { eb = ta * eb + tb; ea = ea * ta; }
                sb = ta * sb + tb; sa = sa * ta; }
            if (FULL) { const float hq = ea * hF + eb;
#pragma unroll
                for (int i = 0; i < 4; ++i) HFL[(16 * ms + 4 * q + i) * 128 + wave * 16 + c] = pa[i] * hq + pb[i];
                hF = sa * hF + sb; }
            else { TB0 = sa * TB0 + sb; TA0 = TA0 * sa; }
        }
#pragma unroll 2
        for (int ms = LCH / 16 - 1; ms >= 0; --ms) {
            LRU_SUB(1, ms)
            float pa[4], pb[4]; float A_ = 1.f, B_ = 0.f;
#pragma unroll
            for (int ii = 0; ii < 4; ++ii) { const int i = 3 - ii; B_ = av[i] * B_ + bv[i]; A_ = A_ * av[i]; pa[i] = A_; pb[i] = B_; }
            float ea = 1.f, eb = 0.f, sa = 1.f, sb = 0.f;
            XQ[lane] = (f32x2){A_, B_};
#pragma unroll
            for (int qi = 0; qi < 4; ++qi) { const int qq = 3 - qi; const f32x2 tq = XQ[c + 16 * qq]; const float ta = tq.x, tb = tq.y;
                if (qq > q) { eb = ta * eb + tb; ea = ea * ta; }
                sb = ta * sb + tb; sa = sa * ta; }
            if (FULL) { const float hq = ea * hB + eb;
#pragma unroll
                for (int i = 0; i < 4; ++i) { const float hb = pa[i] * hq + pb[i];
                    const int tt = 16 * ms + 4 * q + i; const int chb = wave * 16 + c;
                    LAS bf16_t* gp = (LAS bf16_t*)(GT + tt * 256 + (((chb >> 3) ^ (tt & 15)) << 4) + (chb & 7) * 2);
                    const unsigned w = cvt_pk_bf16((HFL[tt * 128 + chb] + hb) * bf2f(*gp), 0.f); *gp = (bf16_t)(w & 0xffffu); }
                hB = sa * hB + sb; }
            else { TB1 = sa * TB1 + sb; TA1 = TA1 * sa; }
        }
#undef LRU_SUB
        if (!FULL) {
            if (q == 0) { const unsigned vo = (unsigned)ch * 8u;
                __builtin_amdgcn_raw_buffer_store_b64((u32x2){__float_as_uint(TA0), __float_as_uint(TB0)}, rTot, (int)vo, (int)((0 * NCHUNK + cidx) * 8192), 0);
                __builtin_amdgcn_raw_buffer_store_b64((u32x2){__float_as_uint(TA1), __float_as_uint(TB1)}, rTot, (int)vo, (int)((1 * NCHUNK + cidx) * 8192), 0); }
        } else {
            __syncthreads();
            const rsrc_t rZ = mk_rsrc_n(ws + WS_Z, 0x7fffffffu);
#pragma unroll
            for (int k = 0; k < 4; ++k) { const int idx = tid + 512 * k, row = idx >> 4, chk = idx & 15;
                const u32x4 v = *(const LAS u32x4*)(GT + row * 256 + ((chk ^ (row & 15)) << 4));
                __builtin_amdgcn_raw_buffer_store_b128(v, rZ, (int)((unsigned)(row * DM + blk * 128 + chk * 8) * 2u), (int)((unsigned)(rowbase + t0) * (DM * 2u)), 0); }
        }
        __syncthreads();
    }
}
__device__ __forceinline__ void lru_prefix_phase(const KArgs& a, int G, int wave_s_) {
    const int tid = opaque_tid(wave_s_);
    const f32x2* TOT = (const f32x2*)(a.ws + WS_TOT); float* PRE = (float*)(a.ws + WS_PRE);
    for (int id = blockIdx.x * 512 + tid; id < 2 * NBATCH * 1024; id += G * 512) {
        const int ch = id & 1023, b = (id >> 10) & 3, dir = id >> 12;
        const f32x2* T = TOT + (size_t)dir * NCHUNK * 1024 + ch; float* Pp = PRE + (size_t)dir * NCHUNK * 1024 + ch;
        float h = 0.f;
#pragma unroll
        for (int k = 0; k < NCC; ++k) { const int cidx = CTX_C0 + b * NCC + (dir ? NCC - 1 - k : k); const f32x2 t = T[(size_t)cidx * 1024]; Pp[(size_t)cidx * 1024] = h; h = t.x * h + t.y; }
#pragma unroll 16
        for (int k = 0; k < NLC; ++k) { const int cidx = b * NLC + (dir ? NLC - 1 - k : k); const f32x2 t = T[(size_t)cidx * 1024]; Pp[(size_t)cidx * 1024] = h; h = t.x * h + t.y; }
    }
}

template <bool F8>
__device__ __forceinline__ void ctx_gemm_resid(const void* A  , const void* Bt, int Kb  , bf16_t* Xctx, const float* gctx, int vcu, int G, int wave_s_) {
    const int tid = opaque_tid(wave_s_), lane = tid & 63, w = __builtin_amdgcn_readfirstlane(tid >> 6), fr = lane & 15, fq = lane >> 4;
    const rsrc_t rA = mk_rsrc_n(A, 0x7fffffffu), rB = mk_rsrc_n(Bt, 0x7fffffffu);
    int sc127 = 0, sc121 = 0;
    if constexpr (F8) { asm volatile("v_mov_b32 %0, 0x7f7f7f7f" : "=v"(sc127)); asm volatile("v_mov_b32 %0, 0x79797979" : "=v"(sc121)); }
    constexpr int KS = F8 ? 128 : 64;
    constexpr int FB = F8 ? 32 : 16;
    for (int u = vcu; u < 256; u += G) {
        const int tr = u >> 4, tc = u & 15;
        const unsigned voA = (unsigned)((tr * 64 + (w & 3) * 16 + fr) * Kb + fq * FB), voB = (unsigned)((tc * 64 + (w >> 2) * 32 + fr) * Kb + fq * FB);
        f32x4 acc[2] = {(f32x4){0.f, 0.f, 0.f, 0.f}, (f32x4){0.f, 0.f, 0.f, 0.f}};
        const int nks = Kb / KS;
#pragma unroll 4
        for (int ks = 0; ks < nks; ++ks) {
            const unsigned so = (unsigned)(ks * KS);
            if constexpr (F8) {
                const u32x4 a0 = __builtin_amdgcn_raw_buffer_load_b128(rA, (int)voA, (int)so, 0), a1 = __builtin_amdgcn_raw_buffer_load_b128(rA, (int)voA, (int)(so + 16), 0);
                const u32x4 b00 = __builtin_amdgcn_raw_buffer_load_b128(rB, (int)voB, (int)so, 0), b01 = __builtin_amdgcn_raw_buffer_load_b128(rB, (int)voB, (int)(so + 16), 0);
                const u32x4 b10 = __builtin_amdgcn_raw_buffer_load_b128(rB, (int)voB, (int)(so + 16 * Kb), 0), b11 = __builtin_amdgcn_raw_buffer_load_b128(rB, (int)voB, (int)(so + 16 * Kb + 16), 0);
                const pg8::i32x8v af = pg8::cat8(__builtin_bit_cast(bf16x8, a0), __builtin_bit_cast(bf16x8, a1));
                acc[0] = __builtin_amdgcn_mfma_scale_f32_16x16x128_f8f6f4(af, pg8::cat8(__builtin_bit_cast(bf16x8, b00), __builtin_bit_cast(bf16x8, b01)), acc[0], 0, 0, 0, sc127, 0, sc121);
                acc[1] = __builtin_amdgcn_mfma_scale_f32_16x16x128_f8f6f4(af, pg8::cat8(__builtin_bit_cast(bf16x8, b10), __builtin_bit_cast(bf16x8, b11)), acc[1], 0, 0, 0, sc127, 0, sc121);
            } else {
                const bf16x8 af = __builtin_bit_cast(bf16x8, __builtin_amdgcn_raw_buffer_load_b128(rA, (int)voA, (int)so, 0));
                const bf16x8 b0 = __builtin_bit_cast(bf16x8, __builtin_amdgcn_raw_buffer_load_b128(rB, (int)voB, (int)so, 0));
                const bf16x8 b1 = __builtin_bit_cast(bf16x8, __builtin_amdgcn_raw_buffer_load_b128(rB, (int)voB, (int)(so + 16 * Kb), 0));
                acc[0] = __builtin_amdgcn_mfma_f32_16x16x32_bf16(af, b0, acc[0], 0, 0, 0);
                acc[1] = __builtin_amdgcn_mfma_f32_16x16x32_bf16(af, b1, acc[1], 0, 0, 0);
            }
        }
#pragma unroll
        for (int n = 0; n < 2; ++n) { const int col = tc * 64 + (w >> 2) * 32 + n * 16 + fr; const float gg = gctx[col];
#pragma unroll
            for (int i = 0; i < 4; ++i) { bf16_t* xp = Xctx + (size_t)(tr * 64 + (w & 3) * 16 + 4 * fq + i) * DM + col;
                const unsigned wv = cvt_pk_bf16(bf2f(*xp) + gg * acc[n][i], 0.f); *xp = (bf16_t)(wv & 0xffffu); } }
    }
}

__global__ void __launch_bounds__(512, 2) dit_fwd(KArgs a) {
    extern __shared__ __attribute__((aligned(16))) unsigned char lds_raw[];
    LAS unsigned char* lds = (LAS unsigned char*)lds_raw;
    volatile LAS unsigned* MISC = (volatile LAS unsigned*)(lds + MISC_OFF);
    const int wave_s_ = __builtin_amdgcn_readfirstlane((int)(threadIdx.x >> 6));
    const int tid = wave_s_ * 64 + lane_id();
    const int G = gridDim.x, bx = blockIdx.x;
    const int vcu = (G % 8 == 0) ? (bx % 8) * (G / 8) + bx / 8 : bx;
    unsigned char* ws = a.ws;
    unsigned* ctl = (unsigned*)(ws + WS_CTL);
    for (int u = tid; u < (LDS_BYTES - RING_BYTES) / 4; u += 512) ((LAS unsigned*)(lds + RING_BYTES))[u] = 0u;
    __syncthreads();
    const int lo = a.ph_lo, hi = a.ph_hi;
    XcdBarrier bar; bar.bar = ctl + CW_BAR; bar.x = 0; bar.st = nullptr;
    if (hi - lo > 1) bar = xcd_barrier_post(ctl + CW_BAR, MISC + 8, wave_s_);
#ifndef PHASE_MASK
#define PHASE_MASK 0xFFFFFFFFu
#endif
#define EN(t) (((PHASE_MASK) >> (t)) & 1u)
#ifndef DBL_MASK
#define DBL_MASK 0u
#endif
#define REP(t) _Pragma("nounroll") for (int rep_ = 0, nrep_ = opaque_int(1 + (int)(((DBL_MASK) >> (t)) & 1u)); rep_ < nrep_; ++rep_)
#define IN(k) (lo <= (k) && (k) < hi)
#ifndef DBL_BAR
#define DBL_BAR 0
#endif
#define SEAM(k) do { if (IN(k) && IN((k) + 1)) { xcd_barrier(bar, wave_s_); if (DBL_BAR) xcd_barrier(bar, wave_s_); } } while (0)
    float* MOD = (float*)(ws + WS_MOD); bf16_t* XS = (bf16_t*)(ws + WS_XS); bf16_t* H = (bf16_t*)(ws + WS_H);

    REP(0) if (EN(0) && IN(0)) { p0_prologue(a, lds, vcu, G, wave_s_); }
    SEAM(0);

    {
        constexpr int lp = 0;
        const int pb = 1 + 17 * lp;
        const int la = 2 * lp, ll = 2 * lp + 1, npost = (lp == 1) ? RL : RT;
        const float* modA = MOD + (size_t)la * 5 * 6144; const float* modL = MOD + (size_t)ll * 5 * 6144;
        REP(1) if (EN(1) && IN(pb + 0)) {
            if (lp == 0) norm_phase<true, false, false, false>(a, lds, G, a.in[I_NMIX] + la * DM, modA, 0, 1024, nullptr, nullptr, RT, wave_s_);
            else norm_phase<false, true, false, false>(a, lds, G, a.in[I_NMIX] + la * DM, modA, 0, 1024, MOD + (size_t)(la - 1) * 5 * 6144 + 5120, nullptr, RT, wave_s_);
        }
        SEAM(pb + 0);
        REP(2) if (EN(2) && IN(pb + 1)) {
            pg8::Gemm g{H, (const bf16_t*)(ws + WS_WQKV) + (size_t)lp * 3072 * 1024, 0, 1024}; pg8::StaticOrder S; S.init(RT, 3072, G, bx);
            pg8::EpiQKV E{(bf16_t*)(ws + WS_Q), (size_t)(WS_K - WS_Q) / 2, (const float*)(ws + WS_ROPE)};
            pg8::gemm_phase<pg8::EpiQKV, pg8::StaticOrder, true, true>(lds, g, S, E, wave_s_);
        }
        SEAM(pb + 1);
        REP(3) if (EN(3) && IN(pb + 2)) {
            const float* lv = a.in[I_LAM] + lp * 256;
            float s01 = 0.f, s23 = 0.f;
            for (int i = 0; i < 64; ++i) { s01 += lv[i] * lv[64 + i]; s23 += lv[128 + i] * lv[192 + i]; }
            const float lam_init = 0.8f - 0.6f * __expf(-0.3f * (float)la);
            att::AttnArgs A{(const bf16_t*)(ws + WS_Q), (const bf16_t*)(ws + WS_K), (const bf16_t*)(ws + WS_V), (bf16_t*)(ws + WS_O), (float*)(ws + WS_STASH), a.in[I_SUBLN] + lp * 128,
                            __expf(s01) - __expf(s23) + lam_init, 1.f - lam_init};
            for (int L = vcu; L < 1024 + 32; L += G) {
                if (L < 1024) { const int bh = L >> 5, qb = L & 31, b = bh >> 3, h = bh & 7;
                    att::attn_unit((LAS char*)lds, A, b * SEQ + qb * 256, h, b * SEQ, RL + b * CTXL, SEQ / 64, SEQ / 64 + CTXL / 64, wave_s_); }
                else { const int b = (L - 1024) >> 3, h = (L - 1024) & 7;
                    att::attn_unit((LAS char*)lds, A, RL + b * CTXL, h, 0, RL + b * CTXL, 0, CTXL / 64, wave_s_); }
            }
        }
        SEAM(pb + 2);
        REP(4) if (EN(4) && IN(pb + 3)) {
            ctx_gemm_resid<false>((const bf16_t*)(ws + WS_O) + (size_t)RL * DM, (const bf16_t*)(ws + WS_WO) + (size_t)lp * 1024 * 1024, 2048, XS + (size_t)RL * DM,
                                  ((rep_ + 1 < nrep_) ? (const float*)(ws + WS_CTL + 65536) : modA + 2048) + 4 * 6144, vcu, G, wave_s_);
            pg8::Gemm g{(const bf16_t*)(ws + WS_O), (const bf16_t*)(ws + WS_WO) + (size_t)lp * 1024 * 1024, 0, 1024}; pg8::StaticOrder S; S.init(RL, 1024, G, bx);
            pg8::EpiResid E{XS, (rep_ + 1 < nrep_) ? (const float*)(ws + WS_CTL + 65536) : modA + 2048, 1.f};
            pg8::gemm_phase<pg8::EpiResid, pg8::StaticOrder, true, true>(lds, g, S, E, wave_s_);
        }
        SEAM(pb + 3);
        REP(5) if (EN(5) && IN(pb + 4)) norm_phase<false, false, false, false, true>(a, lds, G, a.in[I_NFFN] + la * DM, modA, 3072, 4096, nullptr, nullptr, RT, wave_s_);
        SEAM(pb + 4);
        REP(6) if (EN(6) && IN(pb + 5)) {
            pg8::Gemm g{H, ws + WS_WGU + (size_t)lp * 2 * FF * 1024, 0, 1024}; pg8::StaticOrder S; S.init(RT, 2 * FF, G, bx);
            pg8::EpiSwiGLU<true> E{ws + WS_ACT, FF, 1.f};
            pg8::gemm_phase<pg8::EpiSwiGLU<true>, pg8::StaticOrder, true, true, true>(lds, g, S, E, wave_s_);
        }
        SEAM(pb + 5);
        REP(7) if (EN(7) && IN(pb + 6)) {
            ctx_gemm_resid<true>(ws + WS_ACT + (size_t)RL * FF, ws + WS_WDN + (size_t)lp * 1024 * FF, FF, XS + (size_t)RL * DM,
                                 ((rep_ + 1 < nrep_) ? (const float*)(ws + WS_CTL + 65536) : modA + 5120) + 4 * 6144, vcu, G, wave_s_);
            pg8::Gemm g{ws + WS_ACT, ws + WS_WDN + (size_t)lp * 1024 * FF, 0, FF}; pg8::StaticOrder S; S.init(RL, 1024, G, bx);
            pg8::EpiResid E{XS, (rep_ + 1 < nrep_) ? (const float*)(ws + WS_CTL + 65536) : modA + 5120, 1.f};
            pg8::gemm_phase<pg8::EpiResid, pg8::StaticOrder, true, true, true>(lds, g, S, E, wave_s_);
        }
        SEAM(pb + 6);
        REP(8) if (EN(8) && IN(pb + 7)) norm_phase<false, false, false, false>(a, lds, G, a.in[I_NMIX] + ll * DM, modL, 0, 1024, nullptr, nullptr, RT, wave_s_);
        SEAM(pb + 7);
        REP(9) if (EN(9) && IN(pb + 8)) {
            pg8::Gemm g{H, (const bf16_t*)(ws + WS_WIN) + (size_t)lp * 2048 * 1024, 0, 1024}; pg8::StaticOrder S; S.init(RT, 2048, G, bx);
            pg8::EpiWin E{(bf16_t*)(ws + WS_GATE), (size_t)(WS_P - WS_GATE) / 2};
            pg8::gemm_phase<pg8::EpiWin, pg8::StaticOrder, true, true>(lds, g, S, E, wave_s_);
        }
        SEAM(pb + 8);
        REP(10) if (EN(10) && IN(pb + 9)) lru_chunk_phase<false>(a, lds, vcu, G, lp, false, wave_s_);
        SEAM(pb + 9);
        REP(18) if (EN(18) && IN(pb + 10)) lru_prefix_phase(a, G, wave_s_);
        SEAM(pb + 10);
        REP(17) if (EN(17) && IN(pb + 11)) lru_chunk_phase<true>(a, lds, vcu, G, lp, lp == 1, wave_s_);
        SEAM(pb + 11);
        REP(11) if (EN(11) && IN(pb + 12)) {
            if (lp == 0) ctx_gemm_resid<false>((const bf16_t*)(ws + WS_Z) + (size_t)RL * DM, (const bf16_t*)(ws + WS_WOUT) + (size_t)lp * 1024 * 1024, 2048, XS + (size_t)RL * DM,
                                  ((rep_ + 1 < nrep_) ? (const float*)(ws + WS_CTL + 65536) : modL + 2048) + 4 * 6144, vcu, G, wave_s_);
            pg8::Gemm g{(const bf16_t*)(ws + WS_Z), (const bf16_t*)(ws + WS_WOUT) + (size_t)lp * 1024 * 1024, 0, 1024}; pg8::StaticOrder S; S.init(RL, 1024, G, bx);
            pg8::EpiResid E{XS, (rep_ + 1 < nrep_) ? (const float*)(ws + WS_CTL + 65536) : modL + 2048, 1.f};
            pg8::gemm_phase<pg8::EpiResid, pg8::StaticOrder, true, true>(lds, g, S, E, wave_s_);
        }
        SEAM(pb + 12);
        REP(12) if (EN(12) && IN(pb + 13)) norm_phase<false, false, true, false>(a, lds, G, a.in[I_NFFN] + ll * DM, modL, 3072, 4096, nullptr, a.in[I_ROUTER] + (size_t)lp * 1024 * 8, npost, wave_s_);
        SEAM(pb + 13);
        REP(13) if (EN(13) && IN(pb + 14)) moe_place_phase(a, lds, G, npost, wave_s_);
        SEAM(pb + 14);
        REP(14) if (EN(14) && IN(pb + 15)) {
            pg8::Gemm g{ws + WS_FP, ws + WS_MGU + (size_t)lp * 8 * 2 * FE * 1024, (size_t)2 * FE * 1024, 1024};
            pg8::MoeOrder S; S.init((const int*)(ws + WS_SEG), 2 * FE, G, bx);
            pg8::EpiSwiGLU<true> E{ws + WS_ACTP, FE, 1.f};
            pg8::gemm_phase<pg8::EpiSwiGLU<true>, pg8::MoeOrder, true, true, true>(lds, g, S, E, wave_s_);
        }
        SEAM(pb + 15);
        REP(15) if (EN(15) && IN(pb + 16)) {
            pg8::Gemm g{ws + WS_ACTP, ws + WS_MDN + (size_t)lp * 8 * 1024 * FE, (size_t)1024 * FE, FE};
            pg8::MoeOrder S; S.init((const int*)(ws + WS_SEG), 1024, G, bx);
            pg8::EpiBf16 E{(bf16_t*)(ws + WS_YP), 1024, 1.f};
            pg8::gemm_phase<pg8::EpiBf16, pg8::MoeOrder, true, true, true>(lds, g, S, E, wave_s_);
        }
        SEAM(pb + 16);
    }
    {
        constexpr int lp = 1;
        const int pb = 1 + 17 * lp;
        const int la = 2 * lp, ll = 2 * lp + 1, npost = (lp == 1) ? RL : RT;
        const float* modA = MOD + (size_t)la * 5 * 6144; const float* modL = MOD + (size_t)ll * 5 * 6144;
        REP(1) if (EN(1) && IN(pb + 0)) {
            if (lp == 0) norm_phase<true, false, false, false>(a, lds, G, a.in[I_NMIX] + la * DM, modA, 0, 1024, nullptr, nullptr, RT, wave_s_);
            else norm_phase<false, true, false, false>(a, lds, G, a.in[I_NMIX] + la * DM, modA, 0, 1024, MOD + (size_t)(la - 1) * 5 * 6144 + 5120, nullptr, RT, wave_s_);
        }
        SEAM(pb + 0);
        REP(2) if (EN(2) && IN(pb + 1)) {
            pg8::Gemm g{H, (const bf16_t*)(ws + WS_WQKV) + (size_t)lp * 3072 * 1024, 0, 1024}; pg8::StaticOrder S; S.init(RT, 3072, G, bx);
            pg8::EpiQKV E{(bf16_t*)(ws + WS_Q), (size_t)(WS_K - WS_Q) / 2, (const float*)(ws + WS_ROPE)};
            pg8::gemm_phase<pg8::EpiQKV, pg8::StaticOrder, true, true>(lds, g, S, E, wave_s_);
        }
        SEAM(pb + 1);
        REP(3) if (EN(3) && IN(pb + 2)) {
            const float* lv = a.in[I_LAM] + lp * 256;
            float s01 = 0.f, s23 = 0.f;
            for (int i = 0; i < 64; ++i) { s01 += lv[i] * lv[64 + i]; s23 += lv[128 + i] * lv[192 + i]; }
            const float lam_init = 0.8f - 0.6f * __expf(-0.3f * (float)la);
            att::AttnArgs A{(const bf16_t*)(ws + WS_Q), (const bf16_t*)(ws + WS_K), (const bf16_t*)(ws + WS_V), (bf16_t*)(ws + WS_O), (float*)(ws + WS_STASH), a.in[I_SUBLN] + lp * 128,
                            __expf(s01) - __expf(s23) + lam_init, 1.f - lam_init};
            for (int L = vcu; L < 1024 + 32; L += G) {
                if (L < 1024) { const int bh = L >> 5, qb = L & 31, b = bh >> 3, h = bh & 7;
                    att::attn_unit((LAS char*)lds, A, b * SEQ + qb * 256, h, b * SEQ, RL + b * CTXL, SEQ / 64, SEQ / 64 + CTXL / 64, wave_s_); }
                else { const int b = (L - 1024) >> 3, h = (L - 1024) & 7;
                    att::attn_unit((LAS char*)lds, A, RL + b * CTXL, h, 0, RL + b * CTXL, 0, CTXL / 64, wave_s_); }
            }
        }
        SEAM(pb + 2);
        REP(4) if (EN(4) && IN(pb + 3)) {
            ctx_gemm_resid<false>((const bf16_t*)(ws + WS_O) + (size_t)RL * DM, (const bf16_t*)(ws + WS_WO) + (size_t)lp * 1024 * 1024, 2048, XS + (size_t)RL * DM,
                                  ((rep_ + 1 < nrep_) ? (const float*)(ws + WS_CTL + 65536) : modA + 2048) + 4 * 6144, vcu, G, wave_s_);
            pg8::Gemm g{(const bf16_t*)(ws + WS_O), (const bf16_t*)(ws + WS_WO) + (size_t)lp * 1024 * 1024, 0, 1024}; pg8::StaticOrder S; S.init(RL, 1024, G, bx);
            pg8::EpiResid E{XS, (rep_ + 1 < nrep_) ? (const float*)(ws + WS_CTL + 65536) : modA + 2048, 1.f};
            pg8::gemm_phase<pg8::EpiResid, pg8::StaticOrder, true, true>(lds, g, S, E, wave_s_);
        }
        SEAM(pb + 3);
        REP(5) if (EN(5) && IN(pb + 4)) norm_phase<false, false, false, false, true>(a, lds, G, a.in[I_NFFN] + la * DM, modA, 3072, 4096, nullptr, nullptr, RT, wave_s_);
        SEAM(pb + 4);
        REP(6) if (EN(6) && IN(pb + 5)) {
            pg8::Gemm g{H, ws + WS_WGU + (size_t)lp * 2 * FF * 1024, 0, 1024}; pg8::StaticOrder S; S.init(RT, 2 * FF, G, bx);
            pg8::EpiSwiGLU<true> E{ws + WS_ACT, FF, 1.f};
            pg8::gemm_phase<pg8::EpiSwiGLU<true>, pg8::StaticOrder, true, true, true>(lds, g, S, E, wave_s_);
        }
        SEAM(pb + 5);
        REP(7) if (EN(7) && IN(pb + 6)) {
            ctx_gemm_resid<true>(ws + WS_ACT + (size_t)RL * FF, ws + WS_WDN + (size_t)lp * 1024 * FF, FF, XS + (size_t)RL * DM,
                                 ((rep_ + 1 < nrep_) ? (const float*)(ws + WS_CTL + 65536) : modA + 5120) + 4 * 6144, vcu, G, wave_s_);
            pg8::Gemm g{ws + WS_ACT, ws + WS_WDN + (size_t)lp * 1024 * FF, 0, FF}; pg8::StaticOrder S; S.init(RL, 1024, G, bx);
            pg8::EpiResid E{XS, (rep_ + 1 < nrep_) ? (const float*)(ws + WS_CTL + 65536) : modA + 5120, 1.f};
            pg8::gemm_phase<pg8::EpiResid, pg8::StaticOrder, true, true, true>(lds, g, S, E, wave_s_);
        }
        SEAM(pb + 6);
        REP(8) if (EN(8) && IN(pb + 7)) norm_phase<false, false, false, false>(a, lds, G, a.in[I_NMIX] + ll * DM, modL, 0, 1024, nullptr, nullptr, RT, wave_s_);
        SEAM(pb + 7);
        REP(9) if (EN(9) && IN(pb + 8)) {
            pg8::Gemm g{H, (const bf16_t*)(ws + WS_WIN) + (size_t)lp * 2048 * 1024, 0, 1024}; pg8::StaticOrder S; S.init(RT, 2048, G, bx);
            pg8::EpiWin E{(bf16_t*)(ws + WS_GATE), (size_t)(WS_P - WS_GATE) / 2};
            pg8::gemm_phase<pg8::EpiWin, pg8::StaticOrder, true, true>(lds, g, S, E, wave_s_);
        }
        SEAM(pb + 8);
        REP(10) if (EN(10) && IN(pb + 9)) lru_chunk_phase<false>(a, lds, vcu, G, lp, false, wave_s_);
        SEAM(pb + 9);
        REP(18) if (EN(18) && IN(pb + 10)) lru_prefix_phase(a, G, wave_s_);
        SEAM(pb + 10);
        REP(17) if (EN(17) && IN(pb + 11)) lru_chunk_phase<true>(a, lds, vcu, G, lp, lp == 1, wave_s_);
        SEAM(pb + 11);
        REP(11) if (EN(11) && IN(pb + 12)) {
            if (lp == 0) ctx_gemm_resid<false>((const bf16_t*)(ws + WS_Z) + (size_t)RL * DM, (const bf16_t*)(ws + WS_WOUT) + (size_t)lp * 1024 * 1024, 2048, XS + (size_t)RL * DM,
                                  ((rep_ + 1 < nrep_) ? (const float*)(ws + WS_CTL + 65536) : modL + 2048) + 4 * 6144, vcu, G, wave_s_);
            pg8::Gemm g{(const bf16_t*)(ws + WS_Z), (const bf16_t*)(ws + WS_WOUT) + (size_t)lp * 1024 * 1024, 0, 1024}; pg8::StaticOrder S; S.init(RL, 1024, G, bx);
            pg8::EpiResid E{XS, (rep_ + 1 < nrep_) ? (const float*)(ws + WS_CTL + 65536) : modL + 2048, 1.f};
            pg8::gemm_phase<pg8::EpiResid, pg8::StaticOrder, true, true>(lds, g, S, E, wave_s_);
        }
        SEAM(pb + 12);
        REP(12) if (EN(12) && IN(pb + 13)) norm_phase<false, false, true, false>(a, lds, G, a.in[I_NFFN] + ll * DM, modL, 3072, 4096, nullptr, a.in[I_ROUTER] + (size_t)lp * 1024 * 8, npost, wave_s_);
        SEAM(pb + 13);
        REP(13) if (EN(13) && IN(pb + 14)) moe_place_phase(a, lds, G, npost, wave_s_);
        SEAM(pb + 14);
        REP(14) if (EN(14) && IN(pb + 15)) {
            pg8::Gemm g{ws + WS_FP, ws + WS_MGU + (size_t)lp * 8 * 2 * FE * 1024, (size_t)2 * FE * 1024, 1024};
            pg8::MoeOrder S; S.init((const int*)(ws + WS_SEG), 2 * FE, G, bx);
            pg8::EpiSwiGLU<true> E{ws + WS_ACTP, FE, 1.f};
            pg8::gemm_phase<pg8::EpiSwiGLU<true>, pg8::MoeOrder, true, true, true>(lds, g, S, E, wave_s_);
        }
        SEAM(pb + 15);
        REP(15) if (EN(15) && IN(pb + 16)) {
            pg8::Gemm g{ws + WS_ACTP, ws + WS_MDN + (size_t)lp * 8 * 1024 * FE, (size_t)1024 * FE, FE};
            pg8::MoeOrder S; S.init((const int*)(ws + WS_SEG), 1024, G, bx);
            pg8::EpiBf16 E{(bf16_t*)(ws + WS_YP), 1024, 1.f};
            pg8::gemm_phase<pg8::EpiBf16, pg8::MoeOrder, true, true, true>(lds, g, S, E, wave_s_);
        }
        SEAM(pb + 16);
    }
    REP(16) if (EN(16) && IN(35)) norm_phase<false, true, false, true>(a, lds, G, a.in[I_FNORM], nullptr, 0, 0, MOD + (size_t)3 * 5 * 6144 + 5120, nullptr, RL, wave_s_);
#undef IN
#undef SEAM
}

extern "C" void kernel_launch(void* const* d_in, const int* in_sizes, int n_in, void* d_out, int out_size, void* d_ws, size_t ws_size, hipStream_t stream) {
    static int grid = 0;
    if (grid == 0) {
        if (n_in != 25 || in_sizes[0] != RL * DM || out_size != RL * DM || ws_size < WS_END) {
            fprintf(stderr, "kernel_launch: shape mismatch: n_in %d in0 %d out %d ws %zu (need %zu)\n", n_in, n_in > 0 ? in_sizes[0] : -1, out_size, ws_size, (size_t)WS_END); grid = -1; return; }
        int dev = 0, cus = 0, per_cu = 0;
        if (hipGetDevice(&dev) != hipSuccess || hipDeviceGetAttribute(&cus, hipDeviceAttributeMultiprocessorCount, dev) != hipSuccess) { grid = -1; return; }
        if (hipFuncSetAttribute((const void*)dit_fwd, hipFuncAttributeMaxDynamicSharedMemorySize, LDS_BYTES) != hipSuccess) { fprintf(stderr, "kernel_launch: hipFuncSetAttribute failed\n"); grid = -1; return; }
        if (hipOccupancyMaxActiveBlocksPerMultiprocessor(&per_cu, (const void*)dit_fwd, 512, LDS_BYTES) != hipSuccess || per_cu < 1)
            fprintf(stderr, "kernel_launch: note: occupancy query reports %d workgroups per CU\n", per_cu);
        (void)hipGetLastError();
        grid = cus;
        if (grid > 1024) grid = 1024;
    }
    if (grid < 0) return;
    if (hipMemsetAsync((char*)d_ws + WS_CTL, 0, CTL_ZERO_BYTES, stream) != hipSuccess) { fprintf(stderr, "kernel_launch: memset failed\n"); return; }
    KArgs a{};
    for (int i = 0; i < 25; ++i) a.in[i] = (const float*)d_in[i];
    a.out = (float*)d_out; a.ws = (unsigned char*)d_ws;
#if MK_SPLIT
    for (int p = 0; p < NPHASE; ++p) { a.ph_lo = p; a.ph_hi = p + 1; hipLaunchKernelGGL(dit_fwd, dim3(grid), dim3(512), LDS_BYTES, stream, a); }
#else
    a.ph_lo = 0; a.ph_hi = NPHASE; hipLaunchKernelGGL(dit_fwd, dim3(grid), dim3(512), LDS_BYTES, stream, a);
#endif
    const hipError_t le = hipPeekAtLastError();
    if (le != hipSuccess) fprintf(stderr, "kernel_launch: launch failed: %s\n", hipGetErrorName(le));
}
```

```cpp
#define PROBE_MODE 0
#include <hip/hip_runtime.h>
#include <cstdio>
#include <cstdint>

#define LAS __attribute__((address_space(3)))
#define GAS __attribute__((address_space(1)))
typedef unsigned short bf16_t;
typedef short bf16x8 __attribute__((ext_vector_type(8)));
typedef short s16x4 __attribute__((ext_vector_type(4)));
typedef float f32x2 __attribute__((ext_vector_type(2)));
typedef float f32x4 __attribute__((ext_vector_type(4)));
typedef float f32x16 __attribute__((ext_vector_type(16)));
typedef unsigned u32x2 __attribute__((ext_vector_type(2)));
typedef unsigned u32x4 __attribute__((ext_vector_type(4)));
typedef int i32x2 __attribute__((ext_vector_type(2)));

#ifndef PROBE_MODE
#define PROBE_MODE 0
#endif
#ifndef MK_SPLIT
#define MK_SPLIT 0
#endif

constexpr int DM = 1024, NBATCH = 4, SEQ = 8192, CTXL = 256, DEPTH = 4;
constexpr int RL = NBATCH * SEQ, RC = NBATCH * CTXL, RT = RL + RC;
constexpr int NH = 8;
constexpr int FF = 2816, FE = 3584, NE = 8;
constexpr int MP_MAX = 2 * RT + NE * 256;
constexpr float EPS = 1e-6f;
constexpr float QSCALE = 0.125f * 1.4426950408889634f;
constexpr int NPHASE = 36;

constexpr size_t MiB = 1u << 20;
constexpr size_t WS_CTL = 0, CTL_ZERO_BYTES = 256 * 1024;
constexpr size_t WS_MOD = 1 * MiB;
constexpr size_t WS_ROPE = WS_MOD + 512 * 1024;
constexpr size_t WS_CNT = WS_ROPE + 64 * 1024;
constexpr size_t WS_SEG = WS_CNT + 64 * 1024;
constexpr size_t WS_TOKI = 2 * MiB;
constexpr size_t WS_TOKW = WS_TOKI + 512 * 1024;
constexpr size_t WS_TOKE = WS_TOKW + 512 * 1024;
constexpr size_t WS_PROBE = 3 * MiB + 768 * 1024;
constexpr size_t WS_TOT = 4 * MiB;
constexpr size_t WS_PRE = 9 * MiB;
constexpr size_t WS_WQKV = 12 * MiB;
constexpr size_t WS_WO = WS_WQKV + 12 * MiB;
constexpr size_t WS_WGU = WS_WO + 4 * MiB;
constexpr size_t WS_WDN = WS_WGU + 22 * MiB;
constexpr size_t WS_WIN = WS_WDN + 11 * MiB;
constexpr size_t WS_WOUT = WS_WIN + 8 * MiB;
constexpr size_t WS_GW = WS_WOUT + 4 * MiB;
constexpr size_t WS_MGU = WS_GW + 2 * MiB;
constexpr size_t WS_MDN = WS_MGU + 224 * MiB;
constexpr size_t WS_XS = WS_MDN + 112 * MiB;
constexpr size_t WS_H = WS_XS + 132 * MiB;
constexpr size_t WS_S = WS_H + 66 * MiB;
constexpr size_t WS_Q = WS_S, WS_K = WS_S + 66 * MiB, WS_V = WS_S + 132 * MiB, WS_O = WS_S + 198 * MiB, WS_ACT = WS_S + 264 * MiB;
constexpr size_t WS_STASH = WS_S + 446 * MiB;
constexpr size_t WS_GATE = WS_S, WS_P = WS_S + 66 * MiB, WS_HF = WS_S + 132 * MiB, WS_Z = WS_S + 264 * MiB;
constexpr size_t WS_ACTP = WS_S, WS_FP = WS_S + 476 * MiB, WS_YP = WS_S + 476 * MiB;
constexpr size_t WS_END = WS_S + 612 * MiB;
static_assert((size_t)RT * FF * 2 <= 182 * MiB && (size_t)MP_MAX * FE * 2 <= 476 * MiB && (size_t)MP_MAX * DM * 2 <= 136 * MiB, "scratch map");
constexpr int CW_TMO = 0, CW_CODE = 1, CW_BAR = 4096;

constexpr int RING_BYTES = 131072;
constexpr int MISC_OFF = RING_BYTES + 320;
constexpr int LDS_BYTES = 147456;

#define LDS_WAIT() asm volatile("s_waitcnt lgkmcnt(0)" ::: "memory")
#define VM_WAIT() asm volatile("s_waitcnt vmcnt(0)" ::: "memory")
__device__ __forceinline__ unsigned cvt_pk_bf16(float lo, float hi) { unsigned r; asm volatile("v_cvt_pk_bf16_f32 %0, %1, %2" : "=v"(r) : "v"(lo), "v"(hi)); return r; }
__device__ __forceinline__ float bf_lo(unsigned w) { return __uint_as_float(w << 16); }
__device__ __forceinline__ float bf_hi(unsigned w) { return __uint_as_float(w & 0xffff0000u); }
__device__ __forceinline__ float bf2f(bf16_t b) { return __uint_as_float(((unsigned)b) << 16); }
__device__ __forceinline__ float fast_exp2(float x) { return __builtin_amdgcn_exp2f(x); }
__device__ __forceinline__ float fast_rcp(float x) { return __builtin_amdgcn_rcpf(x); }
__device__ __forceinline__ float sigmoid_f(float x) { return fast_rcp(1.f + fast_exp2(-1.4426950408889634f * x)); }
template <int K> __device__ __forceinline__ float xor_swz(float v) { return __int_as_float(__builtin_amdgcn_ds_swizzle(__float_as_int(v), (K << 10) | 0x1F)); }
template <int K> __device__ __forceinline__ int xor_swz_i(int v) { return __builtin_amdgcn_ds_swizzle(v, (K << 10) | 0x1F); }
__device__ __forceinline__ float wave_sum(float v) {
    v += xor_swz<1>(v); v += xor_swz<2>(v); v += xor_swz<4>(v); v += xor_swz<8>(v); v += xor_swz<16>(v);
    const auto rr = __builtin_amdgcn_permlane32_swap(__float_as_uint(v), __float_as_uint(v), false, false);
    return __uint_as_float(rr[0]) + __uint_as_float(rr[1]);
}
__device__ __forceinline__ int wave_sum_i(int v) {
    v += xor_swz_i<1>(v); v += xor_swz_i<2>(v); v += xor_swz_i<4>(v); v += xor_swz_i<8>(v); v += xor_swz_i<16>(v);
    const auto rr = __builtin_amdgcn_permlane32_swap((unsigned)v, (unsigned)v, false, false);
    return (int)(rr[0] + rr[1]);
}
__device__ __forceinline__ int lane_id() { int l; asm volatile("v_mbcnt_lo_u32_b32 %0, -1, 0\n\tv_mbcnt_hi_u32_b32 %0, -1, %0" : "=v"(l)); return l; }
__device__ __forceinline__ int opaque_tid(int wave_s) { int t = wave_s * 64 + lane_id(); asm volatile("" : "+v"(t)); return t; }
__device__ __forceinline__ int opaque_int(int v) { asm volatile("" : "+s"(v)); return v; }
__device__ __forceinline__ unsigned cvt4_fp8(float a, float b, float c, float d) {
    a = __builtin_fminf(__builtin_fmaxf(a, -448.f), 448.f); b = __builtin_fminf(__builtin_fmaxf(b, -448.f), 448.f);
    c = __builtin_fminf(__builtin_fmaxf(c, -448.f), 448.f); d = __builtin_fminf(__builtin_fmaxf(d, -448.f), 448.f);
    int w = 0; w = __builtin_amdgcn_cvt_pk_fp8_f32(a, b, w, false); w = __builtin_amdgcn_cvt_pk_fp8_f32(c, d, w, true); return (unsigned)w; }
constexpr float W8_SCALE = 64.f, W8_INV = 1.f / 64.f;
#define DBL_MASK 0u
#define DBL_BAR 0
#define ATT_ABL 0
#define ATT_PRIO 4
#define PITCH_PAD 0
namespace pg8 {
#define PG8_LAS __attribute__((address_space(3)))
constexpr int BM = 256, BK = 64, HALF = 128, HTB = HALF * BK * 2  , STAGE_BYTES = 8 * HTB, NXCD = 8, WGM = 8;

__host__ __device__ __forceinline__ int lds_byte(int r, int c) { const int st = (r >> 4) * 2 + (c >> 5), rr = r & 15, cc = c & 31, ob = rr * 64 + cc * 2; return st * 1024 + (ob ^ (((ob >> 9) & 1) << 5)); }
__host__ __device__ __forceinline__ void stage_rc(int b, int& R, int& C) { const int st = b / 1024, sb = b % 1024, swz = sb ^ (((sb >> 9) & 1) << 5); R = (st >> 1) * 16 + swz / 64; C = (st & 1) * 32 + (swz % 64) / 2; }

typedef int i32x4v __attribute__((ext_vector_type(4)));
typedef int i32x8v __attribute__((ext_vector_type(8)));
__device__ __forceinline__ i32x8v cat8(bf16x8 lo, bf16x8 hi) { const i32x4v a = __builtin_bit_cast(i32x4v, lo), b = __builtin_bit_cast(i32x4v, hi); return __builtin_shufflevector(a, b, 0, 1, 2, 3, 4, 5, 6, 7); }
struct Unit { int pm, pn, e; };
struct Gemm { const void* A; const void* Bt; size_t bstride; int K; };

struct StaticOrder {
    int nM, nN, nwg, G, c;
    __device__ void init(int M, int N, int G_, int c_) { nM = M / BM; nN = N / BM; nwg = nM * nN; G = G_; c = c_; }
    __device__ bool next(int i, Unit& u) const {
        const long L = (long)i * G + c; if (L >= nwg) return false;
        int wgid = (int)L; { const int q = nwg / NXCD, r = nwg % NXCD, xcd = wgid % NXCD, off = wgid / NXCD; wgid = (xcd < r ? xcd * (q + 1) : r * (q + 1) + (xcd - r) * q) + off; }
        const int nig = WGM * nN, gid = wgid / nig, fm = gid * WGM, gsz = (nM - fm) < WGM ? (nM - fm) : WGM;
        u.pm = fm + ((wgid % nig) % gsz); u.pn = (wgid % nig) / gsz; u.e = 0; return true;
    }
    __device__ __forceinline__ void a_ready(const Unit&) const {}
    __device__ __forceinline__ void done(const Unit&) const {}
};
struct MoeOrder {
    int nM, nN, nwg, G, c; int pend[8];
    __device__ void init(const int* seg  , int N, int G_, int c_) {
#pragma unroll
        for (int e = 0; e < 8; ++e) pend[e] = __builtin_amdgcn_readfirstlane(seg[e + 1]) >> 8;
        nM = pend[7]; nN = N / BM; nwg = nM * nN; G = G_; c = c_; }
    __device__ void init_dense(int M, int N, int G_, int c_) {
#pragma unroll
        for (int e = 0; e < 8; ++e) pend[e] = 0x7fffffff;
        nM = M / BM; nN = N / BM; nwg = nM * nN; G = G_; c = c_; }
    __device__ bool next(int i, Unit& u) const {
        const long L = (long)i * G + c; if (L >= nwg) return false;
        int wgid = (int)L; { const int q = nwg / NXCD, r = nwg % NXCD, xcd = wgid % NXCD, off = wgid / NXCD; wgid = (xcd < r ? xcd * (q + 1) : r * (q + 1) + (xcd - r) * q) + off; }
        const int nig = WGM * nN, gid = wgid / nig, fm = gid * WGM, gsz = (nM - fm) < WGM ? (nM - fm) : WGM;
        u.pm = fm + ((wgid % nig) % gsz); u.pn = (wgid % nig) / gsz;
        int e = 0;
#pragma unroll
        for (int k = 0; k < 7; ++k) e += (u.pm >= pend[k]) ? 1 : 0;
        u.e = e; return true;
    }
    __device__ __forceinline__ void a_ready(const Unit&) const {}
    __device__ __forceinline__ void done(const Unit&) const {}
};


struct EpiQKV {
    static constexpr bool AFTER_DRAIN = false;
    bf16_t* Q; size_t qkv_stride; const float* rope;
    __device__ __forceinline__ void operator()(const f32x4 (&acc)[2][2][4][2], const Unit& u, int wr, int wc, int fr, int fq) const {
        const int which = u.pn >> 2;
        bf16_t* base = Q + (size_t)which * qkv_stride;
        const int col = (u.pn & 3) * 256 + wc * 32 + 8 * fq;
        const int row0 = u.pm * BM + wr * 64 + fr;
        const bool rot = (which < 2) && (u.pm < RL / BM);
        const float qs = which == 0 ? QSCALE : 1.f;
        const int axis = wc & 1;
#pragma unroll
        for (int ai = 0; ai < 2; ++ai)
#pragma unroll
            for (int m = 0; m < 4; ++m) {
                const int row = row0 + ai * HALF + m * 16;
                f32x4 cs = (f32x4){1.f, 1.f, 1.f, 1.f}, sn = (f32x4){0.f, 0.f, 0.f, 0.f};
                if (rot) { const int s = row & (SEQ - 1); const int pos = axis ? (s & 63) : (s >> 6);
                    cs = *(const f32x4*)(rope + pos * 16 + 4 * fq); sn = *(const f32x4*)(rope + 2048 + pos * 16 + 4 * fq); }
                cs = cs * qs; sn = sn * qs;
                bf16_t* rowp = base + (unsigned)(row * DM + col);
#pragma unroll
                for (int bj = 0; bj < 2; ++bj) {
                    const f32x4 x0 = acc[ai][bj][m][0], x1 = acc[ai][bj][m][1];
                    const f32x4 o0 = x0 * cs - x1 * sn, o1 = x1 * cs + x0 * sn;
                    u32x4 w; w.x = cvt_pk_bf16(o0[0], o0[1]); w.y = cvt_pk_bf16(o0[2], o0[3]); w.z = cvt_pk_bf16(o1[0], o1[1]); w.w = cvt_pk_bf16(o1[2], o1[3]);
                    *(u32x4*)(rowp + bj * HALF) = w; }
            }
    }
};
struct EpiResid {
    static constexpr bool AFTER_DRAIN = false;
    bf16_t* X; const float* g; float sc;
    __device__ __forceinline__ void operator()(const f32x4 (&acc)[2][2][4][2], const Unit& u, int wr, int wc, int fr, int fq) const {
        const int mi = u.pm < RL / BM ? (u.pm >> 5) : 4;
        const int col = u.pn * BM + wc * 32 + 4 * fq;
        const float* gp = g + (unsigned)(mi * 6144 + col);
        f32x4 gv[2][2];
#pragma unroll
        for (int bj = 0; bj < 2; ++bj)
#pragma unroll
            for (int n = 0; n < 2; ++n) gv[bj][n] = *(const f32x4*)(gp + bj * HALF + n * 16) * sc;
        const int row0 = u.pm * BM + wr * 64 + fr;
#pragma unroll
        for (int ai = 0; ai < 2; ++ai)
#pragma unroll
            for (int m = 0; m < 4; ++m) { bf16_t* rowp = X + (unsigned)((row0 + ai * HALF + m * 16) * DM + col);
#pragma unroll
                for (int bj = 0; bj < 2; ++bj)
#pragma unroll
                    for (int n = 0; n < 2; ++n) { const u32x2 o = *(const u32x2*)(rowp + bj * HALF + n * 16);
                        const f32x4 r = (f32x4){bf_lo(o.x), bf_hi(o.x), bf_lo(o.y), bf_hi(o.y)} + gv[bj][n] * acc[ai][bj][m][n];
                        u32x2 w; w.x = cvt_pk_bf16(r[0], r[1]); w.y = cvt_pk_bf16(r[2], r[3]); *(u32x2*)(rowp + bj * HALF + n * 16) = w; }
                asm volatile("" ::: "memory"); }
    }
};
template <bool F8OUT> struct EpiSwiGLU {
    static constexpr bool AFTER_DRAIN = false;
    void* O; int ldc; float sc;
    __device__ __forceinline__ void operator()(const f32x4 (&acc)[2][2][4][2], const Unit& u, int wr, int wc, int fr, int fq) const {
        const int col = u.pn * HALF + wc * 32 + 8 * fq;
        const int row0 = u.pm * BM + wr * 64 + fr;
#pragma unroll
        for (int ai = 0; ai < 2; ++ai)
#pragma unroll
            for (int m = 0; m < 4; ++m) {
                f32x4 v[2];
#pragma unroll
                for (int bj = 0; bj < 2; ++bj) { const f32x4 gt = acc[ai][bj][m][0], up = acc[ai][bj][m][1];
#pragma unroll
                    for (int j = 0; j < 4; j += 2) {
                        const f32x2 g2 = {gt[j], gt[j + 1]}, u2 = {up[j], up[j + 1]};
                        const f32x2 e2 = (f32x2){fast_exp2(g2.x), fast_exp2(g2.y)} + 1.f;
                        const f32x2 r2 = {fast_rcp(e2.x), fast_rcp(e2.y)};
                        const f32x2 o2 = (g2 * u2) * r2; v[bj][j] = o2.x; v[bj][j + 1] = o2.y; } }
                if constexpr (F8OUT) { u32x2 w; w.x = cvt4_fp8(v[0][0], v[0][1], v[0][2], v[0][3]); w.y = cvt4_fp8(v[1][0], v[1][1], v[1][2], v[1][3]);
                    *(u32x2*)((unsigned char*)O + (unsigned)((row0 + ai * HALF + m * 16) * ldc + col)) = w; }
                else { u32x4 w; w.x = cvt_pk_bf16(v[0][0], v[0][1]); w.y = cvt_pk_bf16(v[0][2], v[0][3]); w.z = cvt_pk_bf16(v[1][0], v[1][1]); w.w = cvt_pk_bf16(v[1][2], v[1][3]);
                    *(u32x4*)((bf16_t*)O + (unsigned)((row0 + ai * HALF + m * 16) * ldc + col)) = w; }
            }
    }
};
struct EpiWin {
    static constexpr bool AFTER_DRAIN = false;
    bf16_t* GATE; size_t p_stride;
    __device__ __forceinline__ void operator()(const f32x4 (&acc)[2][2][4][2], const Unit& u, int wr, int wc, int fr, int fq) const {
        const int which = u.pn >> 2;
        bf16_t* base = GATE + (size_t)which * p_stride;
        const int col = (u.pn & 3) * 256 + wc * 32 + 8 * fq;
        const int row0 = u.pm * BM + wr * 64 + fr;
#pragma unroll
        for (int ai = 0; ai < 2; ++ai)
#pragma unroll
            for (int m = 0; m < 4; ++m) { bf16_t* rowp = base + (unsigned)((row0 + ai * HALF + m * 16) * DM + col);
#pragma unroll
                for (int bj = 0; bj < 2; ++bj) { f32x4 v0 = acc[ai][bj][m][0], v1 = acc[ai][bj][m][1];
                    if (!which) {
#pragma unroll
                        for (int j = 0; j < 4; ++j) { const float x = v0[j], y = v1[j];
                            v0[j] = x * sigmoid_f(1.5957691216057308f * (x + 0.044715f * x * x * x));
                            v1[j] = y * sigmoid_f(1.5957691216057308f * (y + 0.044715f * y * y * y)); } }
                    u32x4 w; w.x = cvt_pk_bf16(v0[0], v0[1]); w.y = cvt_pk_bf16(v0[2], v0[3]); w.z = cvt_pk_bf16(v1[0], v1[1]); w.w = cvt_pk_bf16(v1[2], v1[3]);
                    *(u32x4*)(rowp + bj * HALF) = w; } }
    }
};
struct EpiBf16 {
    static constexpr bool AFTER_DRAIN = false;
    bf16_t* O; int ldc; float sc;
    __device__ __forceinline__ void operator()(const f32x4 (&acc)[2][2][4][2], const Unit& u, int wr, int wc, int fr, int fq) const {
        const int col = u.pn * BM + wc * 32 + 8 * fq;
        const int row0 = u.pm * BM + wr * 64 + fr;
#pragma unroll
        for (int ai = 0; ai < 2; ++ai)
#pragma unroll
            for (int m = 0; m < 4; ++m) { bf16_t* rowp = O + (unsigned)((row0 + ai * HALF + m * 16) * ldc + col);
#pragma unroll
                for (int bj = 0; bj < 2; ++bj) { const f32x4 v0 = acc[ai][bj][m][0], v1 = acc[ai][bj][m][1];
                    u32x4 w; w.x = cvt_pk_bf16(v0[0], v0[1]); w.y = cvt_pk_bf16(v0[2], v0[3]); w.z = cvt_pk_bf16(v1[0], v1[1]); w.w = cvt_pk_bf16(v1[2], v1[3]);
                    *(u32x4*)(rowp + bj * HALF) = w; } }
    }
};

template <class Epi, class Sched, bool ALIGN_EPI = false, bool SP2 = false, bool F8 = false>
__device__ __forceinline__ void gemm_phase(PG8_LAS unsigned char* lds, const Gemm g, const Sched& S, const Epi& E, int wave_s_) {
    const int tid = opaque_tid(wave_s_), wid = __builtin_amdgcn_readfirstlane(tid >> 6), lane = tid & 63, wr = wid >> 2, wc = wid & 3, fr = lane & 15, fq = lane >> 4;
    int sc127 = 0, sc121 = 0;
    if constexpr (F8) { asm volatile("v_mov_b32 %0, 0x7f7f7f7f" : "=v"(sc127)); asm volatile("v_mov_b32 %0, 0x79797979" : "=v"(sc121)); }
    const int Kb = F8 ? g.K : 2 * g.K, nt = Kb / 128;
    unsigned voffA[2], voffB[2];
#pragma unroll
    for (int i = 0; i < 2; ++i) { int R, C; stage_rc(tid * 16 + i * 8192, R, C); voffA[i] = (unsigned)(R * Kb + 2 * C); voffB[i] = voffA[i]; }
    const unsigned kstep = (unsigned)(BK * 2);
    const unsigned hstep = (unsigned)HALF * Kb;
    const unsigned tstep = 2 * hstep;
    const unsigned ldsw = (unsigned)wid * 1024u;
    const int aoff = lds_byte(wr * 64 + fr, fq * 8), boff = lds_byte(wc * 32 + fr, fq * 8);
#define PG8_SA(b, h) (((b) * 2 + (h)) * HTB)
#define PG8_SB(b, h) ((4 + (b) * 2 + (h)) * HTB)
#define PG8_RSRC_voffA rA
#define PG8_RSRC_voffB rB
#define PG8_STAGE(bufoff, goff, voff) do { _Pragma("unroll") for (int _i = 0; _i < 2; ++_i) \
        __builtin_amdgcn_raw_ptr_buffer_load_lds(PG8_RSRC_##voff, (PG8_LAS void*)(lds + (bufoff) + ldsw + _i * 8192), 16, (int)(voff)[_i], (int)(goff), 0, 0); } while (0)
#define PG8_LDA(dst, b, h) do { _Pragma("unroll") for (int m = 0; m < 4; ++m) _Pragma("unroll") for (int k = 0; k < 2; ++k) dst[m][k] = *(const PG8_LAS bf16x8*)(lds + PG8_SA(b, h) + aoff + m * 2048 + k * 1024); } while (0)
#define PG8_LDB(dst, b, h) do { _Pragma("unroll") for (int n = 0; n < 2; ++n) _Pragma("unroll") for (int k = 0; k < 2; ++k) dst[n][k] = *(const PG8_LAS bf16x8*)(lds + PG8_SB(b, h) + boff + n * 2048 + k * 1024); } while (0)
#define PG8_MMA(ai, bj, At, Bt) do { __builtin_amdgcn_s_setprio(1); _Pragma("unroll") for (int m = 0; m < 4; ++m) _Pragma("unroll") for (int n = 0; n < 2; ++n) { \
        if constexpr (F8) acc[ai][bj][m][n] = __builtin_amdgcn_mfma_scale_f32_16x16x128_f8f6f4(cat8(Bt[n][0], Bt[n][1]), cat8(At[m][0], At[m][1]), acc[ai][bj][m][n], 0, 0, 0, sc121, 0, sc127); \
        else { _Pragma("unroll") for (int k = 0; k < 2; ++k) acc[ai][bj][m][n] = __builtin_amdgcn_mfma_f32_16x16x32_bf16(Bt[n][k], At[m][k], acc[ai][bj][m][n], 0, 0, 0); } } __builtin_amdgcn_s_setprio(0); } while (0)
#define PG8_WAIT_V(n) asm volatile("s_waitcnt vmcnt(" #n ")" ::: "memory")
#define PG8_WAIT_L(n) asm volatile("s_waitcnt lgkmcnt(" #n ")" ::: "memory")
#define PG8_BAR __builtin_amdgcn_s_barrier()
#define PG8_SCHED __builtin_amdgcn_sched_barrier(0)
    Unit cur, nxt; int ui = 0;
    if (!S.next(0, cur)) return;
    f32x4 acc[2][2][4][2];
#pragma unroll
    for (int a = 0; a < 2; ++a)
#pragma unroll
        for (int b = 0; b < 2; ++b)
#pragma unroll
            for (int m = 0; m < 4; ++m)
#pragma unroll
                for (int n = 0; n < 2; ++n) acc[a][b][m][n] = (f32x4){0.f, 0.f, 0.f, 0.f};
    bf16x8 At[4][2], B0[2][2], B1[2][2];
    const __amdgpu_buffer_rsrc_t rA = __builtin_amdgcn_make_buffer_rsrc(const_cast<void*>(g.A), 0, 0x7fffffff, 0x00020000), rB = __builtin_amdgcn_make_buffer_rsrc(const_cast<void*>(g.Bt), 0, 0x7fffffff, 0x00020000);
    unsigned cA = (unsigned)cur.pm * tstep, cB = (unsigned)cur.e * (unsigned)g.bstride + (unsigned)cur.pn * tstep;
    S.a_ready(cur);
    if constexpr (SP2) {
        PG8_STAGE(PG8_SB(0, 0), cB, voffB); PG8_STAGE(PG8_SB(0, 1), cB + hstep, voffB); PG8_STAGE(PG8_SA(0, 0), cA, voffA); PG8_STAGE(PG8_SA(0, 1), cA + hstep, voffA);
        if (wr == 1) PG8_BAR;
        PG8_WAIT_V(2); PG8_BAR;
        PG8_STAGE(PG8_SB(1, 0), cB + kstep, voffB); PG8_STAGE(PG8_SA(1, 0), cA + kstep, voffA); PG8_STAGE(PG8_SB(1, 1), cB + hstep + kstep, voffB);
        PG8_WAIT_V(6); PG8_BAR;
    } else {
        PG8_STAGE(PG8_SB(0, 0), cB, voffB); PG8_STAGE(PG8_SA(0, 0), cA, voffA); PG8_STAGE(PG8_SB(0, 1), cB + hstep, voffB); PG8_STAGE(PG8_SA(0, 1), cA + hstep, voffA);
        if (wr == 1) PG8_BAR;
        PG8_WAIT_V(4); PG8_BAR;
        PG8_STAGE(PG8_SB(1, 0), cB + kstep, voffB); PG8_STAGE(PG8_SA(1, 0), cA + kstep, voffA); PG8_STAGE(PG8_SB(1, 1), cB + hstep + kstep, voffB);
        PG8_WAIT_V(6); PG8_BAR;
    }
    for (;;) {
        const bool has_next = S.next(ui + 1, nxt);
        const unsigned nA = has_next ? (unsigned)nxt.pm * tstep : cA, nB = has_next ? (unsigned)nxt.e * (unsigned)g.bstride + (unsigned)nxt.pn * tstep : cB;
#pragma nounroll
        for (int t = 0; t < nt; t += 2) {
            const bool last = (t == nt - 2);
            const unsigned a1 = cA + (unsigned)(t + 1) * kstep;
            const unsigned a2 = last ? nA : cA + (unsigned)(t + 2) * kstep, b2 = last ? nB : cB + (unsigned)(t + 2) * kstep;
            const unsigned a3 = a2 + kstep, b3 = b2 + kstep;
            if (last && has_next) S.a_ready(nxt);
            if constexpr (SP2) {
            PG8_LDB(B0, 0, 0); PG8_LDB(B1, 0, 1); PG8_SCHED; PG8_LDA(At, 0, 0); PG8_STAGE(PG8_SA(1, 1), a1 + hstep, voffA);
            PG8_WAIT_V(8); PG8_WAIT_L(0); PG8_BAR; PG8_MMA(0, 0, At, B0); PG8_MMA(0, 1, At, B1); PG8_BAR; PG8_SCHED;
            PG8_LDA(At, 0, 1); PG8_STAGE(PG8_SB(0, 0), b2, voffB); PG8_STAGE(PG8_SB(0, 1), b2 + hstep, voffB); PG8_STAGE(PG8_SA(0, 0), a2, voffA);
            PG8_WAIT_V(8); PG8_WAIT_L(0); PG8_BAR; PG8_MMA(1, 0, At, B0); PG8_MMA(1, 1, At, B1); PG8_BAR; PG8_SCHED;
            PG8_LDB(B0, 1, 0); PG8_LDB(B1, 1, 1); PG8_SCHED; PG8_LDA(At, 1, 0); PG8_STAGE(PG8_SA(0, 1), a2 + hstep, voffA);
            PG8_WAIT_V(8); PG8_WAIT_L(0); PG8_BAR; PG8_MMA(0, 0, At, B0); PG8_MMA(0, 1, At, B1); PG8_BAR; PG8_SCHED;
            PG8_LDA(At, 1, 1); PG8_STAGE(PG8_SB(1, 0), b3, voffB); PG8_STAGE(PG8_SB(1, 1), b3 + hstep, voffB); PG8_STAGE(PG8_SA(1, 0), a3, voffA);
            PG8_WAIT_V(8); PG8_WAIT_L(0); PG8_BAR; PG8_MMA(1, 0, At, B0); PG8_MMA(1, 1, At, B1); PG8_BAR; PG8_SCHED;
            } else {
            PG8_LDB(B0, 0, 0); PG8_SCHED; PG8_LDA(At, 0, 0); PG8_STAGE(PG8_SA(1, 1), a1 + hstep, voffA);
            PG8_WAIT_L(8); PG8_BAR; PG8_WAIT_L(0); PG8_MMA(0, 0, At, B0); PG8_BAR; PG8_SCHED;
            PG8_LDB(B1, 0, 1); PG8_STAGE(PG8_SB(0, 0), b2, voffB);
            PG8_BAR; PG8_WAIT_L(0); PG8_MMA(0, 1, At, B1); PG8_BAR;
            PG8_LDA(At, 0, 1); PG8_STAGE(PG8_SA(0, 0), a2, voffA);
            PG8_BAR; PG8_WAIT_L(0); PG8_MMA(1, 0, At, B0); PG8_BAR; PG8_SCHED;
            PG8_STAGE(PG8_SB(0, 1), b2 + hstep, voffB);
            PG8_WAIT_V(6); PG8_BAR; PG8_MMA(1, 1, At, B1); PG8_BAR;
            PG8_LDB(B0, 1, 0); PG8_SCHED; PG8_LDA(At, 1, 0); PG8_STAGE(PG8_SA(0, 1), a2 + hstep, voffA);
            PG8_WAIT_L(8); PG8_BAR; PG8_WAIT_L(0); PG8_MMA(0, 0, At, B0); PG8_BAR; PG8_SCHED;
            PG8_LDB(B1, 1, 1); PG8_STAGE(PG8_SB(1, 0), b3, voffB);
            PG8_BAR; PG8_WAIT_L(0); PG8_MMA(0, 1, At, B1); PG8_BAR;
            PG8_LDA(At, 1, 1); PG8_STAGE(PG8_SA(1, 0), a3, voffA);
            PG8_BAR; PG8_WAIT_L(0); PG8_MMA(1, 0, At, B0); PG8_BAR; PG8_SCHED;
            PG8_STAGE(PG8_SB(1, 1), b3 + hstep, voffB);
            PG8_WAIT_V(6); PG8_BAR; PG8_MMA(1, 1, At, B1); PG8_BAR;
            }
        }
        if constexpr (ALIGN_EPI) { if (wr == 0) PG8_BAR; }
        if constexpr (!Epi::AFTER_DRAIN) { E(acc, cur, wr, wc, fr, fq); S.done(cur); }
        if (!has_next) break;
#pragma unroll
        for (int a = 0; a < 2; ++a)
#pragma unroll
            for (int b = 0; b < 2; ++b)
#pragma unroll
                for (int m = 0; m < 4; ++m)
#pragma unroll
                    for (int n = 0; n < 2; ++n) acc[a][b][m][n] = (f32x4){0.f, 0.f, 0.f, 0.f};
        cur = nxt; cA = nA; cB = nB; ++ui;
        if constexpr (ALIGN_EPI) { if (wr == 1) PG8_BAR; }
    }
    PG8_WAIT_V(0);
    if constexpr (!ALIGN_EPI) { if (wr == 0) PG8_BAR; }
    PG8_BAR;
    if constexpr (Epi::AFTER_DRAIN) { E.fused(acc, cur, wr, wc, fr, fq, lds, wid, lane); S.done(cur); }
#undef PG8_SA
#undef PG8_SB
#undef PG8_STAGE
#undef PG8_RSRC_voffA
#undef PG8_RSRC_voffB
#undef PG8_LDA
#undef PG8_LDB
#undef PG8_MMA
#undef PG8_WAIT_V
#undef PG8_WAIT_L
#undef PG8_BAR
#undef PG8_SCHED
}
}

namespace att {
constexpr int KVBLK = 64;
constexpr int KSLOT = 8192, VSLOT = 16384;
constexpr int OFF_K = 0, OFF_V = 3 * KSLOT, OFF_WS = OFF_V + 4 * VSLOT, ATT_LDS = OFF_WS + 8 * 64 * 4;
static_assert(ATT_LDS <= RING_BYTES, "attention LDS");
constexpr float THRL = 8.f * 1.4426950408889634f;
#define SBAR() __builtin_amdgcn_sched_barrier(0)
#define __syncthreads() do { asm volatile("s_waitcnt lgkmcnt(0)" ::: "memory"); __builtin_amdgcn_s_barrier(); asm volatile("" ::: "memory"); } while (0)
#define ATT_PIN(x) asm volatile("" : "+v"(x))
#define ATT_WAIT_BAR(N) asm volatile("s_waitcnt vmcnt(" #N ") lgkmcnt(0)\n\ts_barrier" ::: "memory")
#define ATT_MFMA(a, b, c) __builtin_amdgcn_mfma_f32_32x32x16_bf16(a, b, c, 0, 0, 0)
__device__ __forceinline__ int crow(int r, int hi) { return (r & 3) + 8 * (r >> 2) + 4 * hi; }
__device__ __forceinline__ unsigned cvtpk(float lo, float hi) { unsigned r; asm("v_cvt_pk_bf16_f32 %0, %1, %2" : "=v"(r) : "v"(lo), "v"(hi)); return r; }
typedef const LAS char* lds_cptr;
typedef short v4i16_t __attribute__((ext_vector_type(4)));
__device__ __forceinline__ s16x4 vtr(lds_cptr p) { return __builtin_bit_cast(s16x4, __builtin_amdgcn_ds_read_tr16_b64_v4i16((LAS v4i16_t*)p)); }
__device__ __forceinline__ bf16x8 kld(lds_cptr p) { return *(const LAS bf16x8*)p; }
#define ATT_MX3(a, b, c) __builtin_fmaxf(__builtin_fmaxf((a), (b)), (c))
__device__ __forceinline__ float rowmax(const f32x16& p0, const f32x16& p1) {
  float a = ATT_MX3(p0[0], p0[1], p1[0]), b = ATT_MX3(p0[2], p0[3], p1[1]); a = ATT_MX3(a, p1[2], p1[3]);
#pragma unroll
  for (int r = 4; r < 16; r += 4) { a = ATT_MX3(a, p0[r], p0[r + 1]); b = ATT_MX3(b, p0[r + 2], p0[r + 3]); a = ATT_MX3(a, p1[r], p1[r + 1]); b = ATT_MX3(b, p1[r + 2], p1[r + 3]); }
  const float m = __builtin_fmaxf(a, b); const auto rr = __builtin_amdgcn_permlane32_swap(__float_as_uint(m), __float_as_uint(m), false, false);
  return __builtin_fmaxf(__uint_as_float(rr[0]), __uint_as_float(rr[1]));
}

struct AttnArgs { const bf16_t* Q; const bf16_t* K; const bf16_t* V; bf16_t* O; float* stash; const float* subln_g; float lam, oscale; };

typedef __amdgpu_buffer_rsrc_t rsrc_t;
__device__ __forceinline__ rsrc_t mk_rsrc(const void* p) { return __builtin_amdgcn_make_buffer_rsrc(const_cast<void*>(p), 0, 0x7fffffff, 0x00020000); }
__device__ __forceinline__ bf16x8 bld16(rsrc_t r, unsigned voff, unsigned soff) { const u32x4 v = __builtin_amdgcn_raw_buffer_load_b128(r, (int)voff, (int)soff, 0); return __builtin_bit_cast(bf16x8, v); }

__device__ __forceinline__ u32x4 mk_rsrc4(const void* p) { const unsigned long long a = (unsigned long long)p; return u32x4{(unsigned)a, (unsigned)(a >> 32) & 0xffffu, 0x7fffffffu, 0x00020000u}; }
__device__ __forceinline__ void dma16(u32x4 rsrc, unsigned voff, unsigned soff, unsigned lds_addr) {
  unsigned sv; asm volatile("s_mov_b32 %0, m0\n\ts_mov_b32 m0, %4\n\ts_nop 0\n\tbuffer_load_dwordx4 %1, %2, %3 offen lds\n\ts_mov_b32 m0, %0" : "=&s"(sv) : "v"(voff), "s"(rsrc), "s"(soff), "s"(lds_addr) : "memory"); }

__device__ __forceinline__ void attn_unit(LAS char* lds, const AttnArgs& A, int qrow0, int h, int klat0, int kctx0, int nlat, int NT, int wave_s_) {
  const int tid = opaque_tid(wave_s_), wid = __builtin_amdgcn_readfirstlane(tid >> 6), lane = tid & 63, r32 = lane & 31, hi = lane >> 5;
  LAS float* wsf = (LAS float*)(lds + OFF_WS) + wid * 64; LAS float* li_l = wsf + 32;
  const lds_cptr kp0 = (lds_cptr)lds + OFF_K + hi * 1024 + r32 * 16;
  const lds_cptr vp0 = (lds_cptr)lds + OFF_V + ((lane >> 4) & 1) * 32 + (lane & 3) * 8 + (4 * hi + ((lane & 15) >> 2)) * 64;
  const unsigned lds0 = (unsigned)(size_t)lds; const unsigned kdst = lds0 + OFF_K + wid * 1024, vdst = lds0 + OFF_V + wid * 1024;
  const unsigned qoff = (unsigned)(r32 * DM + h * 128 + hi * 8) * 2u;
  const unsigned kvo = (unsigned)(lane * DM + h * 128 + wid * 8) * 2u;
  const unsigned vvo = (unsigned)((16 * (wid & 3) + (lane >> 2)) * DM + h * 128 + (wid >> 2) * 32 + (lane & 3) * 8) * 2u;
  const rsrc_t rQ = mk_rsrc(A.Q), rO = mk_rsrc(A.O), rS = mk_rsrc(A.stash); const u32x4 rK4 = mk_rsrc4(A.K), rV4 = mk_rsrc4(A.V);
  const unsigned stash_s = (unsigned)blockIdx.x * (64u * 512u * 4u);
  const unsigned soff = (unsigned)tid * 4u;
#define KROWB(t) ((unsigned)((t) < nlat ? klat0 + (t) * KVBLK : kctx0 + ((t) - nlat) * KVBLK) * (unsigned)(DM * 2))
#define DMA_K(t, ks_) do { const int t_ = (t) < NT ? (t) : NT - 1; dma16(rK4, kvo, KROWB(t_) + ksw, kdst + (unsigned)(ks_)); } while (0)
#define DMA_V1(t, vo_) do { const int t_ = (t) < NT ? (t) : NT - 1; dma16(rV4, vvo, KROWB(t_), vdst + (vo_)); } while (0)
#define DMA_V2(t, vo_) do { const int t_ = (t) < NT ? (t) : NT - 1; dma16(rV4, vvo, KROWB(t_) + 128u, vdst + (vo_) + 8192u); } while (0)
#define VS(t) ((unsigned)((t) & 3) * (unsigned)VSLOT)
#define KRD(j, kp_) kf[j] = kld((kp_) + ((j) >> 1) * 2048 + ((j) & 1) * 512)
#define VRD(f, vp_) do { vlo[f] = vtr((vp_) + (((f) & 3) * 4096 + ((f) >> 2) * 1024)); vhi[f] = vtr((vp_) + (((f) & 3) * 4096 + ((f) >> 2) * 1024 + 512)); } while (0)
#define VFR(f) (bf16x8){vlo[f][0], vlo[f][1], vlo[f][2], vlo[f][3], vhi[f][0], vhi[f][1], vhi[f][2], vhi[f][3]}
#define PAF(k) __builtin_bit_cast(bf16x8, pw[k])
#define RESC() do { if (__builtin_expect(resc, 0)) { asm volatile("s_waitcnt lgkmcnt(0)" ::: "memory"); _Pragma("unroll") for (int d_ = 0; d_ < 4; ++d_) _Pragma("unroll") for (int r = 0; r < 16; ++r) o[d_][r] *= wsf[crow(r, hi)]; } } while (0)
  for (int sw = 0; sw < 2; ++sw) {
    const unsigned ksw = (unsigned)sw * 128u;
    bf16x8 qr[4];
    { const unsigned qs = (unsigned)((qrow0 + wid * 32) * DM + sw * 64) * 2u;
#pragma unroll
      for (int d0 = 0; d0 < 4; ++d0) qr[d0] = bld16(rQ, qoff, qs + d0 * 32); }
    DMA_K(0, 0u); DMA_V1(0, VS(0)); DMA_V2(0, VS(0)); DMA_K(1, (unsigned)KSLOT); DMA_K(2, 2u * KSLOT); DMA_V1(1, VS(1)); DMA_V2(1, VS(1));
    float mhat, l_reg; f32x16 o[4] = {}; f32x16 CA[2], CB[2]; f32x16 negm; bf16x8 kf[8]; s16x4 vlo[16], vhi[16]; u32x4 pw[4]; bool resc = false;
    ATT_WAIT_BAR(6);
#pragma unroll
    for (int j = 0; j < 8; ++j) KRD(j, kp0);
    CA[0] = ATT_MFMA(kf[0], qr[0], f32x16{}); CA[1] = ATT_MFMA(kf[1], qr[0], f32x16{});
#pragma unroll
    for (int j = 2; j < 8; ++j) CA[j & 1] = ATT_MFMA(kf[j], qr[j >> 1], CA[j & 1]);
    { mhat = rowmax(CA[0], CA[1]);
#pragma unroll
      for (int r = 0; r < 16; ++r) { negm[r] = -mhat; CA[0][r] = __builtin_amdgcn_exp2f(CA[0][r] - mhat); CA[1][r] = __builtin_amdgcn_exp2f(CA[1][r] - mhat); }
      ATT_PIN(negm);
      float s0 = 0.f, s1 = 0.f;
#pragma unroll
      for (int r = 0; r < 16; ++r) { s0 += CA[0][r]; s1 += CA[1][r]; }
      l_reg = s0 + s1;
#pragma unroll
      for (int w = 0; w < 16; ++w) pw[w >> 2][w & 3] = cvtpk(CA[(2 * w) >> 4][(2 * w) & 15], CA[(2 * w + 1) >> 4][(2 * w + 1) & 15]); }
    ATT_WAIT_BAR(0);
    DMA_K(3, 0u); DMA_V1(2, VS(2)); DMA_V2(2, VS(2));
#pragma unroll
    for (int j = 0; j < 8; ++j) KRD(j, kp0 + KSLOT);
    CB[0] = ATT_MFMA(kf[0], qr[0], negm); CB[1] = ATT_MFMA(kf[1], qr[0], negm);
#pragma unroll
    for (int j = 2; j < 8; ++j) CB[j & 1] = ATT_MFMA(kf[j], qr[j >> 1], CB[j & 1]);
    { const float rm = rowmax(CB[0], CB[1]);
      if (__builtin_expect(__any(rm > THRL), 0)) { const float dl = __builtin_fmaxf(rm, 0.f); mhat += dl;
#pragma unroll
        for (int r = 0; r < 16; ++r) { CB[0][r] -= dl; CB[1][r] -= dl; negm[r] = -mhat; }
        ATT_PIN(negm);
        const float f = __builtin_amdgcn_exp2f(-dl); l_reg *= f; if (hi == 0) wsf[r32] = f; resc = true; } }
    { const lds_cptr v0_ = vp0 + VS(0); VRD(0, v0_); VRD(1, v0_); VRD(2, v0_); }
    ATT_WAIT_BAR(3);
    unsigned kc_ = KSLOT;
#if ATT_PRIO == 1
    if (wid >= 4) __builtin_amdgcn_s_setprio(1);
#elif ATT_PRIO == 4
    if (wid < 4) __builtin_amdgcn_s_setprio(1);
#elif ATT_PRIO == 5
    if (wid < 4) __builtin_amdgcn_s_setprio(3);
#elif ATT_PRIO == 6
    if (wid & 1) __builtin_amdgcn_s_setprio(1);
#elif ATT_PRIO == 7
    __builtin_amdgcn_s_setprio(1);
#elif ATT_PRIO == 8
    __builtin_amdgcn_s_setprio(3);
#endif
#define ATT_STEP(CC, CN, t, LAST, DOMAX) do { SBAR(); \
    const unsigned k_rd_ = (kc_ == 2u * KSLOT) ? 0u : kc_ + KSLOT;                         \
    const lds_cptr vp_ = vp0 + VS((t) - 1); const lds_cptr vn_ = vp0 + VS(t); const lds_cptr kp_ = kp0 + k_rd_; float ma_ = 0.f, mb_ = 0.f; \
      VRD(3, vp_); SBAR(); o[0] = ATT_MFMA(PAF(0), VFR(0), o[0]); CC[0][0] = __builtin_amdgcn_exp2f(CC[0][0]); CC[0][1] = __builtin_amdgcn_exp2f(CC[0][1]); ATT_PIN(CC[0]); SBAR(); \
      DMA_K((t) + 3, kc_); VRD(4, vp_); SBAR(); o[1] = ATT_MFMA(PAF(0), VFR(1), o[1]); CC[0][2] = __builtin_amdgcn_exp2f(CC[0][2]); CC[0][3] = __builtin_amdgcn_exp2f(CC[0][3]); l_reg += CC[0][0]; l_reg += CC[0][1]; ATT_PIN(CC[0]); ATT_PIN(l_reg); SBAR(); \
      VRD(5, vp_); SBAR(); o[2] = ATT_MFMA(PAF(0), VFR(2), o[2]); CC[0][4] = __builtin_amdgcn_exp2f(CC[0][4]); CC[0][5] = __builtin_amdgcn_exp2f(CC[0][5]); l_reg += CC[0][2]; l_reg += CC[0][3]; ATT_PIN(CC[0]); ATT_PIN(l_reg); SBAR(); \
      VRD(6, vp_); SBAR(); o[3] = ATT_MFMA(PAF(0), VFR(3), o[3]); CC[0][6] = __builtin_amdgcn_exp2f(CC[0][6]); CC[0][7] = __builtin_amdgcn_exp2f(CC[0][7]); l_reg += CC[0][4]; l_reg += CC[0][5]; ATT_PIN(CC[0]); ATT_PIN(l_reg); SBAR(); \
      VRD(7, vp_); SBAR(); o[0] = ATT_MFMA(PAF(1), VFR(4), o[0]); CC[0][8] = __builtin_amdgcn_exp2f(CC[0][8]); CC[0][9] = __builtin_amdgcn_exp2f(CC[0][9]); l_reg += CC[0][6]; l_reg += CC[0][7]; pw[0][0] = cvtpk(CC[0][0], CC[0][1]); ATT_PIN(CC[0]); ATT_PIN(l_reg); ATT_PIN(pw[0]); SBAR(); \
      if (!(LAST)) KRD(0, kp_); SBAR(); o[1] = ATT_MFMA(PAF(1), VFR(5), o[1]); CC[0][10] = __builtin_amdgcn_exp2f(CC[0][10]); CC[0][11] = __builtin_amdgcn_exp2f(CC[0][11]); l_reg += CC[0][8]; l_reg += CC[0][9]; pw[0][1] = cvtpk(CC[0][2], CC[0][3]); ATT_PIN(CC[0]); ATT_PIN(l_reg); ATT_PIN(pw[0]); SBAR(); \
      if (!(LAST)) KRD(2, kp_); SBAR(); o[2] = ATT_MFMA(PAF(1), VFR(6), o[2]); CC[0][12] = __builtin_amdgcn_exp2f(CC[0][12]); CC[0][13] = __builtin_amdgcn_exp2f(CC[0][13]); l_reg += CC[0][10]; l_reg += CC[0][11]; pw[0][2] = cvtpk(CC[0][4], CC[0][5]); ATT_PIN(CC[0]); ATT_PIN(l_reg); ATT_PIN(pw[0]); SBAR(); \
      if (!(LAST)) KRD(4, kp_); SBAR(); o[3] = ATT_MFMA(PAF(1), VFR(7), o[3]); CC[0][14] = __builtin_amdgcn_exp2f(CC[0][14]); CC[0][15] = __builtin_amdgcn_exp2f(CC[0][15]); l_reg += CC[0][12]; l_reg += CC[0][13]; pw[0][3] = cvtpk(CC[0][6], CC[0][7]); ATT_PIN(CC[0]); ATT_PIN(l_reg); ATT_PIN(pw[0]); SBAR(); \
      if (!(LAST)) KRD(6, kp_); SBAR(); if (!(LAST)) CN[0] = ATT_MFMA(kf[0], qr[0], negm); CC[1][0] = __builtin_amdgcn_exp2f(CC[1][0]); CC[1][1] = __builtin_amdgcn_exp2f(CC[1][1]); l_reg += CC[0][14]; l_reg += CC[0][15]; pw[1][0] = cvtpk(CC[0][8], CC[0][9]); ATT_PIN(CC[1]); ATT_PIN(l_reg); ATT_PIN(pw[1]); SBAR(); \
      DMA_V1((t) + 2, VS((t) + 2)); if (!(LAST)) KRD(1, kp_); SBAR(); if (!(LAST)) CN[0] = ATT_MFMA(kf[2], qr[1], CN[0]); CC[1][2] = __builtin_amdgcn_exp2f(CC[1][2]); CC[1][3] = __builtin_amdgcn_exp2f(CC[1][3]); l_reg += CC[1][0]; l_reg += CC[1][1]; pw[1][1] = cvtpk(CC[0][10], CC[0][11]); ATT_PIN(CC[1]); ATT_PIN(l_reg); ATT_PIN(pw[1]); SBAR(); \
      if (!(LAST)) KRD(3, kp_); SBAR(); if (!(LAST)) CN[0] = ATT_MFMA(kf[4], qr[2], CN[0]); CC[1][4] = __builtin_amdgcn_exp2f(CC[1][4]); CC[1][5] = __builtin_amdgcn_exp2f(CC[1][5]); l_reg += CC[1][2]; l_reg += CC[1][3]; pw[1][2] = cvtpk(CC[0][12], CC[0][13]); ATT_PIN(CC[1]); ATT_PIN(l_reg); ATT_PIN(pw[1]); SBAR(); \
      if (!(LAST)) KRD(5, kp_); SBAR(); if (!(LAST)) CN[0] = ATT_MFMA(kf[6], qr[3], CN[0]); CC[1][6] = __builtin_amdgcn_exp2f(CC[1][6]); CC[1][7] = __builtin_amdgcn_exp2f(CC[1][7]); l_reg += CC[1][4]; l_reg += CC[1][5]; pw[1][3] = cvtpk(CC[0][14], CC[0][15]); ATT_PIN(CC[1]); ATT_PIN(l_reg); ATT_PIN(pw[1]); SBAR(); \
      if (!(LAST)) KRD(7, kp_); SBAR(); if (!(LAST)) CN[1] = ATT_MFMA(kf[1], qr[0], negm); CC[1][8] = __builtin_amdgcn_exp2f(CC[1][8]); CC[1][9] = __builtin_amdgcn_exp2f(CC[1][9]); l_reg += CC[1][6]; l_reg += CC[1][7]; ATT_PIN(CC[1]); ATT_PIN(l_reg); SBAR(); \
      VRD(8, vp_); SBAR(); if (!(LAST)) CN[1] = ATT_MFMA(kf[3], qr[1], CN[1]); CC[1][10] = __builtin_amdgcn_exp2f(CC[1][10]); CC[1][11] = __builtin_amdgcn_exp2f(CC[1][11]); l_reg += CC[1][8]; l_reg += CC[1][9]; if (!(LAST) && (DOMAX)) { ma_ = ATT_MX3(CN[0][0], CN[0][1], CN[0][2]); mb_ = ATT_MX3(CN[0][3], CN[0][4], CN[0][5]); ATT_PIN(ma_); ATT_PIN(mb_); } ATT_PIN(CC[1]); ATT_PIN(l_reg); SBAR(); \
      VRD(9, vp_); SBAR(); if (!(LAST)) CN[1] = ATT_MFMA(kf[5], qr[2], CN[1]); CC[1][12] = __builtin_amdgcn_exp2f(CC[1][12]); CC[1][13] = __builtin_amdgcn_exp2f(CC[1][13]); l_reg += CC[1][10]; l_reg += CC[1][11]; if (!(LAST) && (DOMAX)) { ma_ = ATT_MX3(ma_, CN[0][6], CN[0][7]); mb_ = ATT_MX3(mb_, CN[0][8], CN[0][9]); ATT_PIN(ma_); ATT_PIN(mb_); } ATT_PIN(CC[1]); ATT_PIN(l_reg); SBAR(); \
      VRD(10, vp_); SBAR(); if (!(LAST)) CN[1] = ATT_MFMA(kf[7], qr[3], CN[1]); CC[1][14] = __builtin_amdgcn_exp2f(CC[1][14]); CC[1][15] = __builtin_amdgcn_exp2f(CC[1][15]); l_reg += CC[1][12]; l_reg += CC[1][13]; if (!(LAST) && (DOMAX)) { ma_ = ATT_MX3(ma_, CN[0][10], CN[0][11]); mb_ = ATT_MX3(mb_, CN[0][12], CN[0][13]); ATT_PIN(ma_); ATT_PIN(mb_); } ATT_PIN(CC[1]); ATT_PIN(l_reg); SBAR(); \
      VRD(11, vp_); SBAR(); o[0] = ATT_MFMA(PAF(2), VFR(8), o[0]); l_reg += CC[1][14]; l_reg += CC[1][15]; if (!(LAST) && (DOMAX)) { ma_ = ATT_MX3(ma_, CN[0][14], CN[0][15]); ATT_PIN(ma_); ATT_PIN(mb_); } ATT_PIN(l_reg); SBAR(); \
      DMA_V2((t) + 2, VS((t) + 2)); VRD(12, vp_); SBAR(); o[1] = ATT_MFMA(PAF(2), VFR(9), o[1]); if (!(LAST) && (DOMAX)) { mb_ = ATT_MX3(mb_, CN[1][0], CN[1][1]); ma_ = ATT_MX3(ma_, CN[1][2], CN[1][3]); ATT_PIN(ma_); ATT_PIN(mb_); } SBAR(); \
      VRD(13, vp_); SBAR(); o[2] = ATT_MFMA(PAF(2), VFR(10), o[2]); if (!(LAST) && (DOMAX)) { mb_ = ATT_MX3(mb_, CN[1][4], CN[1][5]); ma_ = ATT_MX3(ma_, CN[1][6], CN[1][7]); ATT_PIN(ma_); ATT_PIN(mb_); } SBAR(); \
      VRD(14, vp_); SBAR(); o[3] = ATT_MFMA(PAF(2), VFR(11), o[3]); if (!(LAST) && (DOMAX)) { mb_ = ATT_MX3(mb_, CN[1][8], CN[1][9]); ma_ = ATT_MX3(ma_, CN[1][10], CN[1][11]); ATT_PIN(ma_); ATT_PIN(mb_); } SBAR(); \
      VRD(15, vp_); SBAR(); o[0] = ATT_MFMA(PAF(3), VFR(12), o[0]); pw[2][0] = cvtpk(CC[1][0], CC[1][1]); if (!(LAST) && (DOMAX)) { mb_ = ATT_MX3(mb_, CN[1][12], CN[1][13]); ma_ = ATT_MX3(ma_, CN[1][14], CN[1][15]); ATT_PIN(ma_); ATT_PIN(mb_); } ATT_PIN(pw[2]); SBAR(); \
      VRD(0, vn_); SBAR(); o[1] = ATT_MFMA(PAF(3), VFR(13), o[1]); pw[2][1] = cvtpk(CC[1][2], CC[1][3]); ATT_PIN(pw[2]); SBAR(); \
      VRD(1, vn_); SBAR(); o[2] = ATT_MFMA(PAF(3), VFR(14), o[2]); pw[2][2] = cvtpk(CC[1][4], CC[1][5]); ATT_PIN(pw[2]); SBAR(); \
      VRD(2, vn_); SBAR(); o[3] = ATT_MFMA(PAF(3), VFR(15), o[3]); pw[2][3] = cvtpk(CC[1][6], CC[1][7]); ATT_PIN(pw[2]); SBAR(); \
    pw[3][0] = cvtpk(CC[1][8], CC[1][9]); pw[3][1] = cvtpk(CC[1][10], CC[1][11]); pw[3][2] = cvtpk(CC[1][12], CC[1][13]); pw[3][3] = cvtpk(CC[1][14], CC[1][15]); \
    RESC(); resc = false;                                      \
    if (!(LAST) && (DOMAX)) { float rm = __builtin_fmaxf(ma_, mb_); { const auto rr_ = __builtin_amdgcn_permlane32_swap(__float_as_uint(rm), __float_as_uint(rm), false, false); rm = __builtin_fmaxf(__uint_as_float(rr_[0]), __uint_as_float(rr_[1])); } \
      if (__builtin_expect(__any(rm > THRL), 0)) { const float dl = __builtin_fmaxf(rm, 0.f); mhat += dl;        \
        _Pragma("unroll") for (int r = 0; r < 16; ++r) { CN[0][r] -= dl; CN[1][r] -= dl; negm[r] = -mhat; } \
        ATT_PIN(negm); \
        const float f = __builtin_amdgcn_exp2f(-dl); l_reg *= f; if (hi == 0) wsf[r32] = f; resc = true; } } \
    kc_ = k_rd_; } while (0)
#pragma nounroll
    for (int t = 1; t + 1 < NT; t += 2) {
      ATT_STEP(CB, CA, t, false, false); ATT_WAIT_BAR(3);
      ATT_STEP(CA, CB, t + 1, false, true); ATT_WAIT_BAR(3);
    }
    ATT_STEP(CB, CA, NT - 1, true, false);
#if ATT_PRIO
    __builtin_amdgcn_s_setprio(0);
#endif
    { const lds_cptr vpp = vp0 + VS(NT - 1);
#define DR(f) VRD(f, vpp)
      DR(0); DR(1); DR(2); DR(3); DR(4); DR(5); DR(6); DR(7); DR(8); DR(9); DR(10); DR(11); DR(12); DR(13); DR(14); DR(15);
#undef DR
#define DM_(g) o[(g) & 3] = ATT_MFMA(PAF((g) >> 2), VFR(g), o[(g) & 3])
      DM_(0); DM_(1); DM_(2); DM_(3); DM_(4); DM_(5); DM_(6); DM_(7); DM_(8); DM_(9); DM_(10); DM_(11); DM_(12); DM_(13); DM_(14); DM_(15);
#undef DM_
    }
#undef ATT_STEP
    ATT_WAIT_BAR(0);
    { const auto rr = __builtin_amdgcn_permlane32_swap(__float_as_uint(l_reg), __float_as_uint(l_reg), false, false); l_reg = __uint_as_float(rr[0]) + __uint_as_float(rr[1]); }
    if (hi == 0) li_l[r32] = l_reg; asm volatile("s_waitcnt lgkmcnt(0)" ::: "memory");
    float rli[16];
#pragma unroll
    for (int r = 0; r < 16; ++r) rli[r] = __builtin_amdgcn_rcpf(li_l[crow(r, hi)]);
    if (sw == 0) {
#pragma unroll
      for (int d0 = 0; d0 < 4; ++d0) {
#pragma unroll
        for (int r = 0; r < 16; ++r) __builtin_amdgcn_raw_buffer_store_b32(__float_as_uint(o[d0][r] * rli[r]), rS, (int)soff, (int)(stash_s + (d0 * 16 + r) * 2048), 0);
        asm volatile("" ::: "memory"); }
    } else {
      float ss[16];
#pragma unroll
      for (int r = 0; r < 16; ++r) ss[r] = 0.f;
#pragma unroll
      for (int d0 = 0; d0 < 4; ++d0) {
#pragma unroll
        for (int r = 0; r < 16; ++r) { const float v = __uint_as_float(__builtin_amdgcn_raw_buffer_load_b32(rS, (int)soff, (int)(stash_s + (d0 * 16 + r) * 2048), 0)) - A.lam * (o[d0][r] * rli[r]); o[d0][r] = v; ss[r] += v * v; }
        asm volatile("" ::: "memory"); }
#pragma unroll
      for (int r = 0; r < 16; ++r) {
        ss[r] += xor_swz<1>(ss[r]); ss[r] += xor_swz<2>(ss[r]); ss[r] += xor_swz<4>(ss[r]); ss[r] += xor_swz<8>(ss[r]); ss[r] += xor_swz<16>(ss[r]);
        ss[r] = __builtin_amdgcn_rsqf(ss[r] * (1.f / 128.f) + EPS) * A.oscale; }
      const unsigned obs = (unsigned)((qrow0 + wid * 32) * DM + h * 128) * 2u;
      const unsigned ooff = (unsigned)(4 * hi * DM + r32) * 2u;
#pragma unroll
      for (int d0 = 0; d0 < 4; ++d0) { const float g = A.subln_g[d0 * 32 + r32];
#pragma unroll
        for (int r = 0; r < 16; ++r) { const unsigned w = cvt_pk_bf16(o[d0][r] * ss[r] * g, 0.f);
          __builtin_amdgcn_raw_buffer_store_b16((unsigned short)(w & 0xffffu), rO, (int)ooff, (int)(obs + (unsigned)((((r & 3) + 8 * (r >> 2)) * DM + d0 * 32) * 2)), 0); }
        asm volatile("" ::: "memory"); }
    }
  }
#undef KROWB
#undef DMA_K
#undef DMA_V1
#undef DMA_V2
#undef VS
#undef KRD
#undef VRD
#undef VFR
#undef PAF
#undef RESC
}
}

#define XB_TMO      128
#define XB_XCNT(j)  (256  + 64 * (j))
#define XB_XSUB(j)  (1280 + 64 * (j))
#define XB_XGEN(j)  (2304 + 64 * (j))
#define XB_TOP      3328
#define XB_TOPGEN   3392
#define XCD_BAR_WORDS 3456
#define XB_SPIN_CAP (1u << 18)

__device__ __forceinline__ unsigned xb_ld(unsigned* p)              { return __hip_atomic_load(p, __ATOMIC_RELAXED, __HIP_MEMORY_SCOPE_AGENT); }
__device__ __forceinline__ unsigned xb_add(unsigned* p, unsigned v) { return __hip_atomic_fetch_add(p, v, __ATOMIC_RELAXED, __HIP_MEMORY_SCOPE_AGENT); }
__device__ __forceinline__ unsigned xb_xcc_id() { return (unsigned)__builtin_amdgcn_s_getreg((3 << 11) | 20) & 0xFu; }
#define XB_SPIN(cond, bar) do { unsigned _sp = 0; while (cond) { __builtin_amdgcn_s_sleep(1); \
    if ((++_sp & 255u) == 0u) { if (xb_ld(&(bar)[XB_TMO])) break; if (_sp > XB_SPIN_CAP) { atomicAdd(&(bar)[XB_TMO], 1u); break; } } } } while (0)

struct XcdBarrier {
    unsigned* bar; unsigned x;
    volatile LAS unsigned* st;
};
__device__ __forceinline__ XcdBarrier xcd_barrier_post(unsigned* bar, volatile LAS unsigned* st, int wave_s_) {
    XcdBarrier b; b.bar = bar; b.x = xb_xcc_id(); b.st = st;
    if (wave_s_ == 0 && lane_id() == 0) (void)xb_add(&bar[XB_XCNT(b.x)], 1u);
    return b;
}
__device__ __forceinline__ void xcd_barrier_complete(unsigned* bar, unsigned x, unsigned& nloc, unsigned& nx) {
    const unsigned G = gridDim.x * gridDim.y * gridDim.z;
    unsigned sum, cnt, mine, sp = 0u;
    for (;;) {
        sum = 0u; cnt = 0u; mine = 0u;
#pragma unroll
        for (unsigned j = 0; j < 16; ++j) { const unsigned c = xb_ld(&bar[XB_XCNT(j)]); sum += c; cnt += (c > 0u) ? 1u : 0u; mine = (j == x) ? c : mine; }
        if (sum == G) break;
        __builtin_amdgcn_s_sleep(1);
        if ((++sp & 255u) == 0u) { if (xb_ld(&bar[XB_TMO])) break; if (sp > XB_SPIN_CAP) { atomicAdd(&bar[XB_TMO], 1u); break; } }
    }
    nloc = mine > 0u ? mine : 1u; nx = cnt > 0u ? cnt : 1u;
}
__device__ __forceinline__ void xcd_barrier(const XcdBarrier& b, int wave_s_) {
    asm volatile("s_waitcnt vmcnt(0)" ::: "memory");
    __syncthreads();
    if (wave_s_ == 0 && lane_id() == 0) {
        unsigned* bar = b.bar;
        __builtin_amdgcn_s_waitcnt(0);
        unsigned nloc = b.st[0], nx = b.st[1];
        if (nloc == 0u) { xcd_barrier_complete(bar, b.x, nloc, nx); b.st[0] = nloc; b.st[1] = nx; }
        const unsigned old = xb_add(&bar[XB_XSUB(b.x)], 1u);
        const unsigned gen = old / nloc;
        if (old + 1u == (gen + 1u) * nloc) {
            __builtin_amdgcn_fence(__ATOMIC_RELEASE, "agent");
            asm volatile("s_waitcnt vmcnt(0)" ::: "memory");
            const unsigned og = xb_add(&bar[XB_TOP], 1u);
            const unsigned tg = og / nx;
            if (og + 1u == (tg + 1u) * nx) xb_add(&bar[XB_TOPGEN], 1u);
            else XB_SPIN(xb_ld(&bar[XB_TOPGEN]) == tg, bar);
            __builtin_amdgcn_fence(__ATOMIC_ACQUIRE, "agent");
            xb_add(&bar[XB_XGEN(b.x)], 1u);
            asm volatile("s_waitcnt vmcnt(0)" ::: "memory");
        } else {
            XB_SPIN(xb_ld(&bar[XB_XGEN(b.x)]) == gen, bar);
            __builtin_amdgcn_fence(__ATOMIC_ACQUIRE, "agent");
            asm volatile("s_waitcnt vmcnt(0)" ::: "memory");
        }
    }
    __syncthreads();
}

struct KArgs {
    const float* in[25];
    float* out; unsigned char* ws;
    int ph_lo, ph_hi;
};
enum { I_X = 0, I_C, I_CTX, I_CCTX, I_MODW, I_MODB, I_NMIX, I_NFFN, I_WQKV, I_WO, I_LAM, I_SUBLN, I_WIN, I_CONVW, I_CONVB, I_GATEW, I_GATEB, I_APARAM, I_WOUT,
       I_FGU, I_FDN, I_ROUTER, I_MGU, I_MDN, I_FNORM };

__device__ __forceinline__ int p0_dest_row(int n, int mode, int F) {
    if (mode == 2) { const int nn = n >= F ? 1 : 0, j = n - nn * F;
        return 256 * (j >> 7) + 128 * ((j >> 2) & 1) + 32 * ((j >> 5) & 3) + 16 * nn + 4 * ((j >> 3) & 3) + (j & 3); }
    if (mode == 1 || (mode == 3 && n >= 2048)) { const int s = n & 31; return (n & ~31) + 16 * ((s >> 2) & 1) + 4 * (s >> 3) + (s & 3); }
    return n;
}
__device__ __forceinline__ void p0_transpose_item(const float* W, int K, int N, bf16_t* WT, int mode, int F, LAS float* scr, int item, int lane, float wscale) {
    const int nblk = N / 32, kb = item / nblk, nb = item % nblk, k0 = 64 * kb, n0 = 32 * nb;
    float tmp[32];
#pragma unroll
    for (int i = 0; i < 32; ++i) { const int kk = 2 * i + (lane >> 5); tmp[i] = W[(size_t)(k0 + kk) * N + n0 + (lane & 31)]; }
#pragma unroll
    for (int i = 0; i < 32; ++i) { const int kk = 2 * i + (lane >> 5); scr[kk * 33 + (lane & 31)] = tmp[i]; }
    LDS_WAIT(); asm volatile("" ::: "memory");
    const int c = lane & 7;
#pragma unroll
    for (int j = 0; j < 4; ++j) { const int n = (lane >> 3) + 8 * j; const LAS float* s = scr + (8 * c) * 33 + n;
        u32x4 o; o.x = cvt_pk_bf16(s[0 * 33] * wscale, s[1 * 33] * wscale); o.y = cvt_pk_bf16(s[2 * 33] * wscale, s[3 * 33] * wscale); o.z = cvt_pk_bf16(s[4 * 33] * wscale, s[5 * 33] * wscale); o.w = cvt_pk_bf16(s[6 * 33] * wscale, s[7 * 33] * wscale);
        *(u32x4*)(WT + (size_t)p0_dest_row(n0 + n, mode, F) * K + k0 + 8 * c) = o; }
    LDS_WAIT(); asm volatile("" ::: "memory");
}
__device__ __forceinline__ void p0_transpose_item_f8(const float* W, int K, int N, unsigned char* WT, int mode, int F, LAS float* scr, int item, int lane) {
    const int nblk = N / 32, kb = item / nblk, nb = item % nblk, k0 = 64 * kb, n0 = 32 * nb;
    float tmp[32];
#pragma unroll
    for (int i = 0; i < 32; ++i) { const int kk = 2 * i + (lane >> 5); tmp[i] = W[(size_t)(k0 + kk) * N + n0 + (lane & 31)]; }
#pragma unroll
    for (int i = 0; i < 32; ++i) { const int kk = 2 * i + (lane >> 5); scr[kk * 33 + (lane & 31)] = tmp[i]; }
    LDS_WAIT(); asm volatile("" ::: "memory");
    const int n = lane >> 1, kh = (lane & 1) * 32; const LAS float* s = scr + kh * 33 + n;
    const float wsc = W8_SCALE * (mode == 2 ? ((n0 + n) < F ? -1.4426950408889634f : -0.6931471805599453f) : 1.f);
    u32x4 o0, o1;
    o0.x = cvt4_fp8(s[0 * 33] * wsc, s[1 * 33] * wsc, s[2 * 33] * wsc, s[3 * 33] * wsc);     o0.y = cvt4_fp8(s[4 * 33] * wsc, s[5 * 33] * wsc, s[6 * 33] * wsc, s[7 * 33] * wsc);
    o0.z = cvt4_fp8(s[8 * 33] * wsc, s[9 * 33] * wsc, s[10 * 33] * wsc, s[11 * 33] * wsc);   o0.w = cvt4_fp8(s[12 * 33] * wsc, s[13 * 33] * wsc, s[14 * 33] * wsc, s[15 * 33] * wsc);
    o1.x = cvt4_fp8(s[16 * 33] * wsc, s[17 * 33] * wsc, s[18 * 33] * wsc, s[19 * 33] * wsc); o1.y = cvt4_fp8(s[20 * 33] * wsc, s[21 * 33] * wsc, s[22 * 33] * wsc, s[23 * 33] * wsc);
    o1.z = cvt4_fp8(s[24 * 33] * wsc, s[25 * 33] * wsc, s[26 * 33] * wsc, s[27 * 33] * wsc); o1.w = cvt4_fp8(s[28 * 33] * wsc, s[29 * 33] * wsc, s[30 * 33] * wsc, s[31 * 33] * wsc);
    unsigned char* d = WT + (size_t)p0_dest_row(n0 + n, mode, F) * K + k0 + kh;
    *(u32x4*)d = o0; *(u32x4*)(d + 16) = o1;
    LDS_WAIT(); asm volatile("" ::: "memory");
}
__device__ __forceinline__ void p0_prologue(const KArgs& a, LAS unsigned char* lds, int vcu, int G, int wave_s_) {
    const int tid = opaque_tid(wave_s_), lane = tid & 63, wave = __builtin_amdgcn_readfirstlane(tid >> 6);
    unsigned char* ws = a.ws;
    LAS float* sl = (LAS float*)(lds + 73728);
    LAS float* red = (LAS float*)(lds + 98304);
    for (int i = tid; i < 5 * 1024; i += 512) { const float x = i < 4096 ? a.in[I_C][i] : a.in[I_CCTX][i - 4096]; sl[i] = x * sigmoid_f(x); }
    __syncthreads();
    float* MOD = (float*)(ws + WS_MOD);
    for (int u = vcu; u < DEPTH * 96; u += G) {
        const int layer = u / 96, n0 = (u % 96) * 64;
        const float* W = a.in[I_MODW] + (size_t)layer * 1024 * 6144 + n0 + lane;
        float acc[5] = {0.f, 0.f, 0.f, 0.f, 0.f};
        const int kbeg = wave * 128;
#pragma unroll 8
        for (int k = 0; k < 128; ++k) { const float w = W[(size_t)(kbeg + k) * 6144];
#pragma unroll
            for (int v = 0; v < 5; ++v) acc[v] += sl[v * 1024 + kbeg + k] * w; }
#pragma unroll
        for (int v = 0; v < 5; ++v) red[(wave * 5 + v) * 64 + lane] = acc[v];
        __syncthreads();
        if (wave < 5) { float s = a.in[I_MODB][layer * 6144 + n0 + lane];
#pragma unroll
            for (int w = 0; w < 8; ++w) s += red[(w * 5 + wave) * 64 + lane];
            MOD[(layer * 5 + wave) * 6144 + n0 + lane] = s; }
        __syncthreads();
    }
    if (vcu == 0) { float* rope = (float*)(ws + WS_ROPE);
        for (int i = tid; i < 2048; i += 512) { const int pos = i >> 4, f = i & 15; const float inv = exp2f(-(float)f * (13.287712379549449f / 16.f)); const float ang = (float)pos * inv;
            rope[i] = __cosf(ang); rope[2048 + i] = __sinf(ang); } }
    LAS float* scr = (LAS float*)(lds + wave * 8448);
    const int gw = vcu * 8 + wave, NGW = G * 8;
    constexpr int N_QKV = 2 * 16 * 96, N_WO = 2 * 16 * 32, N_FGU = 2 * 16 * 176, N_FDN = 2 * 44 * 32, N_WIN = 2 * 16 * 64, N_WOUT = 2 * 16 * 32, N_GW = 64 * 8,
                  N_MGU = 16 * 16 * 224, N_MDN = 16 * 56 * 32;
    constexpr int NITEMS = N_QKV + N_WO + N_FGU + N_FDN + N_WIN + N_WOUT + N_GW + N_MGU + N_MDN;
    for (int it = gw; it < NITEMS; it += NGW) {
        int r = it; const float* src; bf16_t* dst; int K, N, mode = 0, F = 0, per, mat; bool f8 = false; float wscale = 1.f;
        if (r < N_QKV) { per = 16 * 96; mat = r / per; r -= mat * per; K = 1024; N = 3072; mode = 3; src = a.in[I_WQKV] + (size_t)mat * K * N; dst = (bf16_t*)(ws + WS_WQKV) + (size_t)mat * K * N; }
        else if ((r -= N_QKV) < N_WO) { per = 16 * 32; mat = r / per; r -= mat * per; K = 1024; N = 1024; src = a.in[I_WO] + (size_t)mat * K * N; dst = (bf16_t*)(ws + WS_WO) + (size_t)mat * K * N; }
        else if ((r -= N_WO) < N_FGU) { per = 16 * 176; mat = r / per; r -= mat * per; K = 1024; N = 2 * FF; mode = 2; F = FF; f8 = true; src = a.in[I_FGU] + (size_t)mat * K * N; dst = (bf16_t*)(ws + WS_WGU + (size_t)mat * K * N); }
        else if ((r -= N_FGU) < N_FDN) { per = 44 * 32; mat = r / per; r -= mat * per; K = FF; N = 1024; f8 = true; src = a.in[I_FDN] + (size_t)mat * K * N; dst = (bf16_t*)(ws + WS_WDN + (size_t)mat * K * N); }
        else if ((r -= N_FDN) < N_WIN) { per = 16 * 64; mat = r / per; r -= mat * per; K = 1024; N = 2048; mode = 1; src = a.in[I_WIN] + (size_t)mat * K * N; dst = (bf16_t*)(ws + WS_WIN) + (size_t)mat * K * N; }
        else if ((r -= N_WIN) < N_WOUT) { per = 16 * 32; mat = r / per; r -= mat * per; K = 1024; N = 1024; src = a.in[I_WOUT] + (size_t)mat * K * N; dst = (bf16_t*)(ws + WS_WOUT) + (size_t)mat * K * N; }
        else if ((r -= N_WOUT) < N_GW) { per = 8; mat = r / per; r -= mat * per; K = 128; N = 128; wscale = -1.4426950408889634f; src = a.in[I_GATEW] + (size_t)mat * K * N; dst = (bf16_t*)(ws + WS_GW) + (size_t)mat * K * N; }
        else if ((r -= N_GW) < N_MGU) { per = 16 * 224; mat = r / per; r -= mat * per; K = 1024; N = 2 * FE; mode = 2; F = FE; f8 = true; src = a.in[I_MGU] + (size_t)mat * K * N; dst = (bf16_t*)(ws + WS_MGU + (size_t)mat * K * N); }
        else { r -= N_MGU; per = 56 * 32; mat = r / per; r -= mat * per; K = FE; N = 1024; mode = 1; f8 = true; src = a.in[I_MDN] + (size_t)mat * K * N; dst = (bf16_t*)(ws + WS_MDN + (size_t)mat * K * N); }
        if (f8) p0_transpose_item_f8(src, K, N, (unsigned char*)dst, mode, F, scr, r, lane);
        else p0_transpose_item(src, K, N, dst, mode, F, scr, r, lane, wscale);
    }
}

template <bool SRC_IN, bool COMBINE, bool ROUTER, bool FINAL, bool F8OUT = false>
__device__ __forceinline__ void norm_phase(const KArgs& a, LAS unsigned char* lds, int G, const float* gain, const float* modl  , int sh_off, int sc_off,
                                           const float* g2prev  , const float* router_w, int nrows, int wave_s_) {
    const int tid = opaque_tid(wave_s_), lane = tid & 63, wave = __builtin_amdgcn_readfirstlane(tid >> 6), bx = blockIdx.x;
    unsigned char* ws = a.ws;
    bf16_t* XS = (bf16_t*)(ws + WS_XS); bf16_t* H = (bf16_t*)(ws + WS_H); const bf16_t* YP = (const bf16_t*)(ws + WS_YP);
    i32x2* TOKI = (i32x2*)(ws + WS_TOKI); f32x2* TOKW = (f32x2*)(ws + WS_TOKW);
    const int rpw = (nrows + G - 1) / G, r0 = bx * rpw, r1 = (r0 + rpw) < nrows ? (r0 + rpw) : nrows;
    LAS float* RW = (LAS float*)lds;
    LAS int* lcnt = (LAS int*)(lds + 32768);
    int cnt[8] = {0, 0, 0, 0, 0, 0, 0, 0};
    if (ROUTER) {
        for (int i = tid; i < 8192; i += 512) RW[(i & 7) * 1024 + (i >> 3)] = router_w[i];
        if (tid < 8) lcnt[tid] = 0;
        __syncthreads();
    }
    struct NRow { f32x4 xf[4]; u32x2 xw[4]; u32x2 y1[4], y2[4]; f32x2 ww; };
    auto issue = [&](int row, i32x2 pp, NRow& R) {
        if (SRC_IN) { const float* xr = row < RL ? a.in[I_X] + (size_t)row * DM : a.in[I_CTX] + (size_t)(row - RL) * DM;
#pragma unroll
            for (int j = 0; j < 4; ++j) R.xf[j] = *(const f32x4*)(xr + 4 * lane + 256 * j); }
        else { const bf16_t* xr = XS + (size_t)row * DM;
#pragma unroll
            for (int j = 0; j < 4; ++j) R.xw[j] = *(const u32x2*)(xr + 4 * lane + 256 * j); }
        if (COMBINE) { R.ww = TOKW[row];
            const bf16_t* y1 = YP + (size_t)pp.x * DM; const bf16_t* y2 = YP + (size_t)pp.y * DM;
#pragma unroll
            for (int j = 0; j < 4; ++j) { R.y1[j] = *(const u32x2*)(y1 + 4 * lane + 256 * j); R.y2[j] = *(const u32x2*)(y2 + 4 * lane + 256 * j); } }
    };
    f32x4 gv[4], scv[4], shv[4], g2v[4]; int mi_cur = -1;
#pragma unroll
    for (int j = 0; j < 4; ++j) gv[j] = *(const f32x4*)(gain + 4 * lane + 256 * j);
    constexpr int NB = (SRC_IN || COMBINE || ROUTER) ? 2 : 4;
    for (int rowb = r0 + wave; rowb < r1; rowb += 8 * NB) {
      NRow R[NB];
      { i32x2 pp[NB];
#pragma unroll
        for (int k = 0; k < NB; ++k) { pp[k] = (i32x2){0, 0}; if (COMBINE && rowb + 8 * k < r1) pp[k] = TOKI[rowb + 8 * k]; }
#pragma unroll
        for (int k = 0; k < NB; ++k) if (rowb + 8 * k < r1) issue(rowb + 8 * k, pp[k], R[k]);
        asm volatile("" ::: "memory"); __builtin_amdgcn_sched_barrier(0); }
#pragma unroll
      for (int k = 0; k < NB; ++k) {
        const int row = rowb + 8 * k; if (row >= r1) break;
        const NRow& cur = R[k];
        const bool lat = row < RL; const int mi = lat ? (row >> 13) : 4;
        f32x4 v[4];
        if (SRC_IN) {
#pragma unroll
            for (int j = 0; j < 4; ++j) v[j] = cur.xf[j]; }
        else {
#pragma unroll
            for (int j = 0; j < 4; ++j) { const u32x2 w = cur.xw[j]; v[j] = (f32x4){bf_lo(w.x), bf_hi(w.x), bf_lo(w.y), bf_hi(w.y)}; } }
        if (mi != mi_cur) {
            mi_cur = mi;
            if (!FINAL) { const float* ml = modl + mi * 6144;
#pragma unroll
                for (int j = 0; j < 4; ++j) { scv[j] = *(const f32x4*)(ml + sc_off + 4 * lane + 256 * j) + 1.f; shv[j] = *(const f32x4*)(ml + sh_off + 4 * lane + 256 * j); } }
            if (COMBINE) { const float* g2 = g2prev + mi * 6144;
#pragma unroll
                for (int j = 0; j < 4; ++j) g2v[j] = *(const f32x4*)(g2 + 4 * lane + 256 * j); }
        }
        if (COMBINE) {
            const f32x2 ww = cur.ww;
#pragma unroll
            for (int j = 0; j < 4; ++j) { const u32x2 a1 = cur.y1[j], a2 = cur.y2[j]; const f32x4 gg = g2v[j];
                v[j].x += gg.x * (ww.x * bf_lo(a1.x) + ww.y * bf_lo(a2.x)); v[j].y += gg.y * (ww.x * bf_hi(a1.x) + ww.y * bf_hi(a2.x));
                v[j].z += gg.z * (ww.x * bf_lo(a1.y) + ww.y * bf_lo(a2.y)); v[j].w += gg.w * (ww.x * bf_hi(a1.y) + ww.y * bf_hi(a2.y)); }
        }
        if ((SRC_IN || COMBINE) && !FINAL) {
#pragma unroll
            for (int j = 0; j < 4; ++j) { u32x2 w; w.x = cvt_pk_bf16(v[j].x, v[j].y); w.y = cvt_pk_bf16(v[j].z, v[j].w); *(u32x2*)(XS + (size_t)row * DM + 4 * lane + 256 * j) = w; }
        }
        float ss = 0.f;
#pragma unroll
        for (int j = 0; j < 4; ++j) ss += (v[j].x * v[j].x + v[j].y * v[j].y) + (v[j].z * v[j].z + v[j].w * v[j].w);
        const float rs = __builtin_amdgcn_rsqf(wave_sum(ss) * (1.f / DM) + EPS);
        if (FINAL) {
#pragma unroll
            for (int j = 0; j < 4; ++j) *(f32x4*)(a.out + (size_t)row * DM + 4 * lane + 256 * j) = v[j] * rs * gv[j];
        } else {
            float lg[8] = {0.f, 0.f, 0.f, 0.f, 0.f, 0.f, 0.f, 0.f};
#pragma unroll
            for (int j = 0; j < 4; ++j) {
                const f32x4 o = v[j] * rs * gv[j] * scv[j] + shv[j];
                if (ROUTER || F8OUT) *(unsigned*)((unsigned char*)H + (size_t)row * DM + 4 * lane + 256 * j) = cvt4_fp8(o.x, o.y, o.z, o.w);
                else { u32x2 w; w.x = cvt_pk_bf16(o.x, o.y); w.y = cvt_pk_bf16(o.z, o.w); *(u32x2*)(H + (size_t)row * DM + 4 * lane + 256 * j) = w; }
                if (ROUTER) {
#pragma unroll
                    for (int e = 0; e < 8; ++e) { const f32x4 rw = *(const LAS f32x4*)(RW + e * 1024 + 4 * lane + 256 * j); lg[e] += (o.x * rw.x + o.y * rw.y) + (o.z * rw.z + o.w * rw.w); } }
            }
            if (ROUTER) {
                { const bool h5 = (lane & 32) != 0, h4 = (lane & 16) != 0, h3 = (lane & 8) != 0;
                  float v4[4], v2[2], v1;
#pragma unroll
                  for (int k = 0; k < 4; ++k) { const float snd = h5 ? lg[k] : lg[k + 4], kp = h5 ? lg[k + 4] : lg[k];
                      const auto rr = __builtin_amdgcn_permlane32_swap(__float_as_uint(snd), __float_as_uint(snd), false, false);
                      v4[k] = kp + __uint_as_float(h5 ? rr[0] : rr[1]); }
#pragma unroll
                  for (int k = 0; k < 2; ++k) { const float snd = h4 ? v4[k] : v4[k + 2], kp = h4 ? v4[k + 2] : v4[k]; v2[k] = kp + xor_swz<16>(snd); }
                  { const float snd = h3 ? v2[0] : v2[1], kp = h3 ? v2[1] : v2[0]; v1 = kp + xor_swz<8>(snd); }
                  v1 += xor_swz<4>(v1); v1 += xor_swz<2>(v1); v1 += xor_swz<1>(v1);
#pragma unroll
                  for (int e = 0; e < 8; ++e) lg[e] = __int_as_float(__builtin_amdgcn_readlane(__float_as_int(v1), 32 * (e >> 2) + 16 * ((e >> 1) & 1) + 8 * (e & 1))); }
                int e1 = 0; float l1 = lg[0];
#pragma unroll
                for (int e = 1; e < 8; ++e) if (lg[e] > l1) { l1 = lg[e]; e1 = e; }
                int e2 = -1; float l2 = -3.0e38f;
#pragma unroll
                for (int e = 0; e < 8; ++e) if (e != e1 && lg[e] > l2) { l2 = lg[e]; e2 = e; }
                e1 = __builtin_amdgcn_readfirstlane(e1); e2 = __builtin_amdgcn_readfirstlane(e2);
                const float w1 = fast_rcp(1.f + __expf(l2 - l1));
                if (lane == 0) { ((i32x2*)(ws + WS_TOKE))[row] = (i32x2){e1, e2}; TOKW[row] = (f32x2){w1, 1.f - w1}; }
#pragma unroll
                for (int e = 0; e < 8; ++e) cnt[e] += (e == e1 || e == e2) ? 1 : 0;
            }
        }
      }
    }
    if (ROUTER) {
        if (lane == 0) {
#pragma unroll
            for (int e = 0; e < 8; ++e) atomicAdd((int*)(lcnt + e), cnt[e]); }
        __syncthreads();
        if (tid < 8) ((int*)(ws + WS_CNT))[bx * 8 + tid] = lcnt[tid];
    }
}

__device__ __forceinline__ void moe_place_phase(const KArgs& a, LAS unsigned char* lds, int G, int nrows, int wave_s_) {
    const int tid = opaque_tid(wave_s_), lane = tid & 63, wave = __builtin_amdgcn_readfirstlane(tid >> 6), bx = blockIdx.x;
    unsigned char* ws = a.ws;
    const int* CNT = (const int*)(ws + WS_CNT); int* SEG = (int*)(ws + WS_SEG);
    i32x2* TOKI = (i32x2*)(ws + WS_TOKI); const bf16_t* H = (const bf16_t*)(ws + WS_H); bf16_t* FP = (bf16_t*)(ws + WS_FP);
    const int rpw = (nrows + G - 1) / G, r0 = bx * rpw, r1 = (r0 + rpw) < nrows ? (r0 + rpw) : nrows, nr = r1 > r0 ? r1 - r0 : 0;
    LAS int* tot = (LAS int*)lds; LAS int* pre = tot + 8; LAS int* base = tot + 16; LAS i32x2* plist = (LAS i32x2*)(lds + 256);
    { int t = 0, p = 0;
        for (int g = lane; g < G; g += 64) { const int c = CNT[g * 8 + wave]; t += c; p += (g < bx) ? c : 0; }
        t = wave_sum_i(t); p = wave_sum_i(p);
        if (lane == 0) { tot[wave] = t; pre[wave] = p; } }
    for (int i = tid; i < nr; i += 512) plist[i] = ((const i32x2*)(ws + WS_TOKE))[r0 + i];
    __syncthreads();
    if (wave == 0) {
        int b[8]; int off = 0;
#pragma unroll
        for (int e = 0; e < 8; ++e) { b[e] = off + pre[e]; if (bx == 0 && lane == 0) SEG[e] = off; off += (tot[e] + 255) & ~255; }
        if (bx == 0 && lane == 0) SEG[8] = off;
        const unsigned long long lt = (1ull << lane) - 1ull;
        for (int c0 = 0; c0 < nr; c0 += 64) {
            const int i = c0 + lane; const bool valid = i < nr; const i32x2 ee = valid ? plist[i] : (i32x2){-1, -1};
            int p1 = 0, p2 = 0;
#pragma unroll
            for (int e = 0; e < 8; ++e) { const unsigned long long mm = __ballot(valid && (ee.x == e || ee.y == e));
                const int before = b[e] + __popcll(mm & lt);
                if (ee.x == e) p1 = before; if (ee.y == e) p2 = before;
                b[e] += __popcll(mm); }
            if (valid) plist[i] = (i32x2){p1, p2};
        }
    }
    __syncthreads();
    for (int i = tid; i < nr; i += 512) TOKI[r0 + i] = plist[i];
    for (int i = wave; i < nr; i += 32) {
        u32x4 xr[4]; i32x2 pq[4];
#pragma unroll
        for (int k = 0; k < 4; ++k) { const int ii = i + 8 * k; pq[k] = (i32x2){0, 0}; xr[k] = (u32x4){0u, 0u, 0u, 0u};
            if (ii < nr) { pq[k] = plist[ii]; xr[k] = ((const u32x4*)((const unsigned char*)H + (size_t)(r0 + ii) * DM))[lane]; } }
        asm volatile("" ::: "memory"); __builtin_amdgcn_sched_barrier(0);
#pragma unroll
        for (int k = 0; k < 4; ++k) if (i + 8 * k < nr) {
            ((u32x4*)((unsigned char*)FP + (size_t)pq[k].x * DM))[lane] = xr[k]; ((u32x4*)((unsigned char*)FP + (size_t)pq[k].y * DM))[lane] = xr[k]; }
    }
}

typedef __amdgpu_buffer_rsrc_t rsrc_t;
__device__ __forceinline__ rsrc_t mk_rsrc_n(const void* p, unsigned nbytes) { return __builtin_amdgcn_make_buffer_rsrc(const_cast<void*>(p), 0, (int)nbytes, 0x00020000); }
constexpr int LCH = 128, NLC = SEQ / LCH  , NCC = CTXL / LCH  , NCHUNK = NBATCH * (NLC + NCC)  , CTX_C0 = NBATCH * NLC  ;
template <bool FULL>
__device__ __forceinline__ void lru_chunk_phase(const KArgs& a, LAS unsigned char* lds, int vcu, int G, int j  , bool skip_ctx_out, int wave_s_) {
    const int tid = opaque_tid(wave_s_), lane = tid & 63, wave = __builtin_amdgcn_readfirstlane(tid >> 6), c = lane & 15, q = lane >> 4;
    unsigned char* ws = a.ws;
    const bf16_t* P = (const bf16_t*)(ws + WS_P); const bf16_t* GW = (const bf16_t*)(ws + WS_GW);
    LAS unsigned char* U = lds;
    LAS unsigned char* GT = lds + 32768;
    LAS f32x2* XQ = (LAS f32x2*)(lds + 135168) + wave * 64;
    LAS float* HFL = (LAS float*)(lds + 65536);
    const rsrc_t rTot = mk_rsrc_n(ws + WS_TOT, 2u * NCHUNK * 1024u * 8u), rPre = mk_rsrc_n(ws + WS_PRE, 2u * NCHUNK * 1024u * 4u);
    const int cgp = tid & 15, sg = tid >> 4;
    int cur_blk = -1;
    bf16x8 Wf[2][2][4];
    float br[2], bi[2], Lc2[2];
    for (int u = vcu; u < NCHUNK * 8; u += G) {
        const int cidx = u >> 3, blk = u & 7;
        const bool is_ctx = cidx >= CTX_C0;
        if (FULL && skip_ctx_out && is_ctx) continue;
        const int b = is_ctx ? (cidx - CTX_C0) >> 1 : cidx >> 6, kc = is_ctx ? (cidx - CTX_C0) & 1 : cidx & 63, t0 = kc * LCH, rowbase = is_ctx ? RL + b * CTXL : b * SEQ, seglen = is_ctx ? CTXL : SEQ;
        const int ch = blk * 128 + wave * 16 + c;
        if (blk != cur_blk) {
            cur_blk = blk;
#pragma unroll
            for (int d = 0; d < 2; ++d) {
#pragma unroll
                for (int g = 0; g < 2; ++g) { const bf16_t* gp = GW + ((size_t)(((j * 2 + d) * 2 + g) * 8 + blk) * 128 + wave * 16 + c) * 128 + q * 8;
#pragma unroll
                    for (int ks = 0; ks < 4; ++ks) Wf[d][g][ks] = *(const bf16x8*)(gp + ks * 32); }
                br[d] = -1.4426950408889634f * a.in[I_GATEB][((j * 2 + d) * 2 + 0) * DM + ch]; bi[d] = -1.4426950408889634f * a.in[I_GATEB][((j * 2 + d) * 2 + 1) * DM + ch];
                const float ap = a.in[I_APARAM][(j * 2 + d) * DM + ch];
                Lc2[d] = 8.f * 1.4426950408889634f * (fminf(ap, 0.f) - log1pf(__expf(-fabsf(ap))));
            }
        }
        const rsrc_t rP = mk_rsrc_n(P + (size_t)rowbase * DM, (unsigned)seglen * DM * 2u);
        u32x4 pr[7];
#pragma unroll
        for (int r = 0; r < 7; ++r) pr[r] = __builtin_amdgcn_raw_buffer_load_b128(rP, (int)((unsigned)((t0 + 4 * sg - 2 + r) * DM + blk * 128 + cgp * 8) * 2u), 0, 0);
        float hF = 0.f, hB = 0.f;
        if (FULL) {
            const rsrc_t rG = mk_rsrc_n(ws + WS_GATE, 0x7fffffffu);
            u32x4 gt[4];
#pragma unroll
            for (int k = 0; k < 4; ++k) { const int idx = tid + 512 * k, row = idx >> 4, chk = idx & 15;
                gt[k] = __builtin_amdgcn_raw_buffer_load_b128(rG, (int)((unsigned)(row * DM + blk * 128 + chk * 8) * 2u), (int)((unsigned)(rowbase + t0) * (DM * 2u)), 0); }
            hF = __uint_as_float(__builtin_amdgcn_raw_buffer_load_b32(rPre, (int)((unsigned)ch * 4u), (int)((0 * NCHUNK + cidx) * 4096), 0));
            hB = __uint_as_float(__builtin_amdgcn_raw_buffer_load_b32(rPre, (int)((unsigned)ch * 4u), (int)((1 * NCHUNK + cidx) * 4096), 0));
#pragma unroll
            for (int k = 0; k < 4; ++k) { const int idx = tid + 512 * k, row = idx >> 4, chk = idx & 15; *(LAS u32x4*)(GT + row * 256 + ((chk ^ (row & 15)) << 4)) = gt[k]; }
        }
        float cw[4][8], cb[8];
        {
            const float* wp = a.in[I_CONVW] + (size_t)j * 4 * DM + blk * 128 + cgp * 8;
#pragma unroll
            for (int t = 0; t < 4; ++t) { const f32x4 w0 = *(const f32x4*)(wp + t * DM), w1 = *(const f32x4*)(wp + t * DM + 4);
                cw[t][0] = w0.x; cw[t][1] = w0.y; cw[t][2] = w0.z; cw[t][3] = w0.w; cw[t][4] = w1.x; cw[t][5] = w1.y; cw[t][6] = w1.z; cw[t][7] = w1.w; }
            const float* bp = a.in[I_CONVB] + (size_t)j * DM + blk * 128 + cgp * 8; const f32x4 b0 = *(const f32x4*)bp, b1 = *(const f32x4*)(bp + 4);
            cb[0] = b0.x; cb[1] = b0.y; cb[2] = b0.z; cb[3] = b0.w; cb[4] = b1.x; cb[5] = b1.y; cb[6] = b1.z; cb[7] = b1.w;
        }
#pragma unroll
        for (int k = 0; k < 4; ++k) {
            float acc[8];
#pragma unroll
            for (int e = 0; e < 8; ++e) acc[e] = cb[e];
#pragma unroll
            for (int tap = 0; tap < 4; ++tap) { const u32x4 pv = pr[k + tap];
                acc[0] += cw[tap][0] * bf_lo(pv.x); acc[1] += cw[tap][1] * bf_hi(pv.x); acc[2] += cw[tap][2] * bf_lo(pv.y); acc[3] += cw[tap][3] * bf_hi(pv.y);
                acc[4] += cw[tap][4] * bf_lo(pv.z); acc[5] += cw[tap][5] * bf_hi(pv.z); acc[6] += cw[tap][6] * bf_lo(pv.w); acc[7] += cw[tap][7] * bf_hi(pv.w); }
            u32x4 w; w.x = cvt_pk_bf16(acc[0], acc[1]); w.y = cvt_pk_bf16(acc[2], acc[3]); w.z = cvt_pk_bf16(acc[4], acc[5]); w.w = cvt_pk_bf16(acc[6], acc[7]);
            const int tt = 4 * sg + k;
            *(LAS u32x4*)(U + tt * 256 + ((cgp ^ (tt & 15)) << 4)) = w;
        }
        __syncthreads();
#define LRU_SUB(d, ms) \
            f32x4 aR = (f32x4){br[d], br[d], br[d], br[d]}, aI = (f32x4){bi[d], bi[d], bi[d], bi[d]};     \
            { const int m = 16 * (ms) + c; \
              _Pragma("unroll") for (int ks = 0; ks < 4; ++ks) { const bf16x8 af = *(const LAS bf16x8*)(U + m * 256 + (((ks * 4 + q) ^ c) << 4)); \
                aR = __builtin_amdgcn_mfma_f32_16x16x32_bf16(af, Wf[d][0][ks], aR, 0, 0, 0); aI = __builtin_amdgcn_mfma_f32_16x16x32_bf16(af, Wf[d][1][ks], aI, 0, 0, 0); } } \
            float av[4], bv[4]; \
            _Pragma("unroll") for (int i = 0; i < 4; i += 2) {                                          \
                const int chb = wave * 16 + c; const int t0_ = 16 * (ms) + 4 * q + i, t1_ = t0_ + 1; \
                const f32x2 uv = {bf2f(*(const LAS bf16_t*)(U + t0_ * 256 + (((chb >> 3) ^ (t0_ & 15)) << 4) + (chb & 7) * 2)), bf2f(*(const LAS bf16_t*)(U + t1_ * 256 + (((chb >> 3) ^ (t1_ & 15)) << 4) + (chb & 7) * 2))}; \
                const f32x2 eR = (f32x2){fast_exp2(aR[i]), fast_exp2(aR[i + 1])} + 1.f, eI = (f32x2){fast_exp2(aI[i]), fast_exp2(aI[i + 1])} + 1.f; \
                const f32x2 rr = {fast_rcp(eR.x), fast_rcp(eR.y)}, ig = {fast_rcp(eI.x), fast_rcp(eI.y)}; \
                const f32x2 la = rr * Lc2[d]; const f32x2 at = {fast_exp2(la.x), fast_exp2(la.y)}; \
                const f32x2 om = (f32x2){1.f, 1.f} - at * at; \
                const f32x2 sq = {__builtin_sqrtf(fmaxf(om.x, 0.f)), __builtin_sqrtf(fmaxf(om.y, 0.f))}; \
                const f32x2 b2 = sq * (ig * uv); \
                av[i] = at.x; av[i + 1] = at.y; bv[i] = b2.x; bv[i + 1] = b2.y; }
        float TA0 = 1.f, TB0 = 0.f, TA1 = 1.f, TB1 = 0.f;
#pragma unroll 2
        for (int ms = 0; ms < LCH / 16; ++ms) {
            LRU_SUB(0, ms)
            float pa[4], pb[4]; float A_ = 1.f, B_ = 0.f;
#pragma unroll
            for (int i = 0; i < 4; ++i) { B_ = av[i] * B_ + bv[i]; A_ = A_ * av[i]; pa[i] = A_; pb[i] = B_; }
            float ea = 1.f, eb = 0.f, sa = 1.f, sb = 0.f;
            XQ[lane] = (f32x2){A_, B_};
#pragma unroll
            for (int qq = 0; qq < 4; ++qq) { const f32x2 tq = XQ[c + 16 * qq]; const float ta = tq.x, tb = tq.y;
                if (qq < q) { eb = ta * eb + tb; ea = ea * ta; }
                sb = ta * sb + tb; sa = sa * ta; }
            if (FULL) { const float hq = ea * hF + eb;
#pragma unroll
                for (int i = 0; i < 4; ++i) HFL[(16 * ms + 4 * q + i) * 128 + wave * 16 + c] = pa[i] * hq + pb[i];
                hF = sa * hF + sb; }
            else { TB0 = sa * TB0 + sb; TA0 = TA0 * sa; }
        }
#pragma unroll 2
        for (int ms = LCH / 16 - 1; ms >= 0; --ms) {
            LRU_SUB(1, ms)
            float pa[4], pb[4]; float A_ = 1.f, B_ = 0.f;
#pragma unroll
            for (int ii = 0; ii < 4; ++ii) { const int i = 3 - ii; B_ = av[i] * B_ + bv[i]; A_ = A_ * av[i]; pa[i] = A_; pb[i] = B_; }
            float ea = 1.f, eb = 0.f, sa = 1.f, sb = 0.f;
            XQ[lane] = (f32x2){A_, B_};
#pragma unroll
            for (int qi = 0; qi < 4; ++qi) { const int qq = 3 - qi; const f32x2 tq = XQ[c + 16 * qq]; const float ta = tq.x, tb = tq.y;
                if (qq > q) { eb = ta * eb + tb; ea = ea * ta; }
                sb = ta * sb + tb; sa = sa * ta; }
            if (FULL) { const float hq = ea * hB + eb;
#pragma unroll
                for (int i = 0; i < 4; ++i) { const float hb = pa[i] * hq + pb[i];
                    const int tt = 16 * ms + 4 * q + i; const int chb = wave * 16 + c;
                    LAS bf16_t* gp = (LAS bf16_t*)(GT + tt * 256 + (((chb >> 3) ^ (tt & 15)) << 4) + (chb & 7) * 2);
                    const unsigned w = cvt_pk_bf16((HFL[tt * 128 + chb] + hb) * bf2f(*gp), 0.f); *gp = (bf16_t)(w & 0xffffu); }
                hB = sa * hB + sb; }
            else { TB1 = sa * TB1 + sb; TA1 = TA1 * sa; }
        }
#undef LRU_SUB
        if (!FULL) {
            if (q == 0) { const unsigned vo = (unsigned)ch * 8u;
                __builtin_amdgcn_raw_buffer_store_b64((u32x2){__float_as_uint(TA0), __float_as_uint(TB0)}, rTot, (int)vo, (int)((0 * NCHUNK + cidx) * 8192), 0);
                __builtin_amdgcn_raw_buffer_store_b64((u32x2){__float_as_uint(TA1), __float_as_uint(TB1)}, rTot, (int)vo, (int)((1 * NCHUNK + cidx) * 8192), 0); }
        } else {
            __syncthreads();
            const rsrc_t rZ = mk_rsrc_n(ws + WS_Z, 0x7fffffffu);
#pragma unroll
            for (int k = 0; k < 4; ++k) { const int idx = tid + 512 * k, row = idx >> 4, chk = idx & 15;
                const u32x4 v = *(const LAS u32x4*)(GT + row * 256 + ((chk ^ (row & 15)) << 4));
                __builtin_amdgcn_raw_buffer_store_b128(v, rZ, (int)((unsigned)(row * DM + blk * 128 + chk * 8) * 2u), (int)((unsigned)(rowbase + t0) * (DM * 2u)), 0); }
        }
        __syncthreads();
    }
}
__device__ __forceinline__ void lru_prefix_phase(const KArgs& a, int G, int wave_s_) {
    const int tid = opaque_tid(wave_s_);
    const f32x2* TOT = (const f32x2*)(a.ws + WS_TOT); float* PRE = (float*)(a.ws + WS_PRE);
    for (int id = blockIdx.x * 512 + tid; id < 2 * NBATCH * 1024; id += G * 512) {
        const int ch = id & 1023, b = (id >> 10) & 3, dir = id >> 12;
        const f32x2* T = TOT + (size_t)dir * NCHUNK * 1024 + ch; float* Pp = PRE + (size_t)dir * NCHUNK * 1024 + ch;
        float h = 0.f;
#pragma unroll
        for (int k = 0; k < NCC; ++k) { const int cidx = CTX_C0 + b * NCC + (dir ? NCC - 1 - k : k); const f32x2 t = T[(size_t)cidx * 1024]; Pp[(size_t)cidx * 1024] = h; h = t.x * h + t.y; }
#pragma unroll 16
        for (int k = 0; k < NLC; ++k) { const int cidx = b * NLC + (dir ? NLC - 1 - k : k); const f32x2 t = T[(size_t)cidx * 1024]; Pp[(size_t)cidx * 1024] = h; h = t.x * h + t.y; }
    }
}

template <bool F8>
__device__ __forceinline__ void ctx_gemm_resid(const void* A  , const void* Bt, int Kb  , bf16_t* Xctx, const float* gctx, int vcu, int G, int wave_s_) {
    const int tid = opaque_tid(wave_s_), lane = tid & 63, w = __builtin_amdgcn_readfirstlane(tid >> 6), fr = lane & 15, fq = lane >> 4;
    const rsrc_t rA = mk_rsrc_n(A, 0x7fffffffu), rB = mk_rsrc_n(Bt, 0x7fffffffu);
    int sc127 = 0, sc121 = 0;
    if constexpr (F8) { asm volatile("v_mov_b32 %0, 0x7f7f7f7f" : "=v"(sc127)); asm volatile("v_mov_b32 %0, 0x79797979" : "=v"(sc121)); }
    constexpr int KS = F8 ? 128 : 64;
    constexpr int FB = F8 ? 32 : 16;
    for (int u = vcu; u < 256; u += G) {
        const int tr = u >> 4, tc = u & 15;
        const unsigned voA = (unsigned)((tr * 64 + (w & 3) * 16 + fr) * Kb + fq * FB), voB = (unsigned)((tc * 64 + (w >> 2) * 32 + fr) * Kb + fq * FB);
        f32x4 acc[2] = {(f32x4){0.f, 0.f, 0.f, 0.f}, (f32x4){0.f, 0.f, 0.f, 0.f}};
        const int nks = Kb / KS;
#pragma unroll 4
        for (int ks = 0; ks < nks; ++ks) {
            const unsigned so = (unsigned)(ks * KS);
            if constexpr (F8) {
                const u32x4 a0 = __builtin_amdgcn_raw_buffer_load_b128(rA, (int)voA, (int)so, 0), a1 = __builtin_amdgcn_raw_buffer_load_b128(rA, (int)voA, (int)(so + 16), 0);
                const u32x4 b00 = __builtin_amdgcn_raw_buffer_load_b128(rB, (int)voB, (int)so, 0), b01 = __builtin_amdgcn_raw_buffer_load_b128(rB, (int)voB, (int)(so + 16), 0);
                const u32x4 b10 = __builtin_amdgcn_raw_buffer_load_b128(rB, (int)voB, (int)(so + 16 * Kb), 0), b11 = __builtin_amdgcn_raw_buffer_load_b128(rB, (int)voB, (int)(so + 16 * Kb + 16), 0);
                const pg8::i32x8v af = pg8::cat8(__builtin_bit_cast(bf16x8, a0), __builtin_bit_cast(bf16x8, a1));
                acc[0] = __builtin_amdgcn_mfma_scale_f32_16x16x128_f8f6f4(af, pg8::cat8(__builtin_bit_cast(bf16x8, b00), __builtin_bit_cast(bf16x8, b01)), acc[0], 0, 0, 0, sc127, 0, sc121);
                acc[1] = __builtin_amdgcn_mfma_scale_f32_16x16x128_f8f6f4(af, pg8::cat8(__builtin_bit_cast(bf16x8, b10), __builtin_bit_cast(bf16x8, b11)), acc[1], 0, 0, 0, sc127, 0, sc121);
            } else {
                const bf16x8 af = __builtin_bit_cast(bf16x8, __builtin_amdgcn_raw_buffer_load_b128(rA, (int)voA, (int)so, 0));
                const bf16x8 b0 = __builtin_bit_cast(bf16x8, __builtin_amdgcn_raw_buffer_load_b128(rB, (int)voB, (int)so, 0));
                const bf16x8 b1 = __builtin_bit_cast(bf16x8, __builtin_amdgcn_raw_buffer_load_b128(rB, (int)voB, (int)(so + 16 * Kb), 0));
                acc[0] = __builtin_amdgcn_mfma_f32_16x16x32_bf16(af, b0, acc[0], 0, 0, 0);
                acc[1] = __builtin_amdgcn_mfma_f32_16x16x32_bf16(af, b1, acc[1], 0, 0, 0);
            }
        }
#pragma unroll
        for (int n = 0; n < 2; ++n) { const int col = tc * 64 + (w >> 2) * 32 + n * 16 + fr; const float gg = gctx[col];
#pragma unroll
            for (int i = 0; i < 4; ++i) { bf16_t* xp = Xctx + (size_t)(tr * 64 + (w & 3) * 16 + 4 * fq + i) * DM + col;
                const unsigned wv = cvt_pk_bf16(bf2f(*xp) + gg * acc[n][i], 0.f); *xp = (bf16_t)(wv & 0xffffu); } }
    }
}

__global__ void __launch_bounds__(512, 2) dit_fwd(KArgs a) {
    extern __shared__ __attribute__((aligned(16))) unsigned char lds_raw[];
    LAS unsigned char* lds = (LAS unsigned char*)lds_raw;
    volatile LAS unsigned* MISC = (volatile LAS unsigned*)(lds + MISC_OFF);
    const int wave_s_ = __builtin_amdgcn_readfirstlane((int)(threadIdx.x >> 6));
    const int tid = wave_s_ * 64 + lane_id();
    const int G = gridDim.x, bx = blockIdx.x;
    const int vcu = (G % 8 == 0) ? (bx % 8) * (G / 8) + bx / 8 : bx;
    unsigned char* ws = a.ws;
    unsigned* ctl = (unsigned*)(ws + WS_CTL);
    for (int u = tid; u < (LDS_BYTES - RING_BYTES) / 4; u += 512) ((LAS unsigned*)(lds + RING_BYTES))[u] = 0u;
    __syncthreads();
    const int lo = a.ph_lo, hi = a.ph_hi;
    XcdBarrier bar; bar.bar = ctl + CW_BAR; bar.x = 0; bar.st = nullptr;
    if (hi - lo > 1) bar = xcd_barrier_post(ctl + CW_BAR, MISC + 8, wave_s_);
#ifndef PHASE_MASK
#define PHASE_MASK 0xFFFFFFFFu
#endif
#define EN(t) (((PHASE_MASK) >> (t)) & 1u)
#ifndef DBL_MASK
#define DBL_MASK 0u
#endif
#define REP(t) _Pragma("nounroll") for (int rep_ = 0, nrep_ = opaque_int(1 + (int)(((DBL_MASK) >> (t)) & 1u)); rep_ < nrep_; ++rep_)
#define IN(k) (lo <= (k) && (k) < hi)
#ifndef DBL_BAR
#define DBL_BAR 0
#endif
#define SEAM(k) do { if (IN(k) && IN((k) + 1)) { xcd_barrier(bar, wave_s_); if (DBL_BAR) xcd_barrier(bar, wave_s_); } } while (0)
    float* MOD = (float*)(ws + WS_MOD); bf16_t* XS = (bf16_t*)(ws + WS_XS); bf16_t* H = (bf16_t*)(ws + WS_H);

    REP(0) if (EN(0) && IN(0)) { p0_prologue(a, lds, vcu, G, wave_s_); }
    SEAM(0);

    {
        constexpr int lp = 0;
        const int pb = 1 + 17 * lp;
        const int la = 2 * lp, ll = 2 * lp + 1, npost = (lp == 1) ? RL : RT;
        const float* modA = MOD + (size_t)la * 5 * 6144; const float* modL = MOD + (size_t)ll * 5 * 6144;
        REP(1) if (EN(1) && IN(pb + 0)) {
            if (lp == 0) norm_phase<true, false, false, false>(a, lds, G, a.in[I_NMIX] + la * DM, modA, 0, 1024, nullptr, nullptr, RT, wave_s_);
            else norm_phase<false, true, false, false>(a, lds, G, a.in[I_NMIX] + la * DM, modA, 0, 1024, MOD + (size_t)(la - 1) * 5 * 6144 + 5120, nullptr, RT, wave_s_);
        }
        SEAM(pb + 0);
        REP(2) if (EN(2) && IN(pb + 1)) {
            pg8::Gemm g{H, (const bf16_t*)(ws + WS_WQKV) + (size_t)lp * 3072 * 1024, 0, 1024}; pg8::StaticOrder S; S.init(RT, 3072, G, bx);
            pg8::EpiQKV E{(bf16_t*)(ws + WS_Q), (size_t)(WS_K - WS_Q) / 2, (const float*)(ws + WS_ROPE)};
            pg8::gemm_phase<pg8::EpiQKV, pg8::StaticOrder, true, true>(lds, g, S, E, wave_s_);
        }
        SEAM(pb + 1);
        REP(3) if (EN(3) && IN(pb + 2)) {
            const float* lv = a.in[I_LAM] + lp * 256;
            float s01 = 0.f, s23 = 0.f;
            for (int i = 0; i < 64; ++i) { s01 += lv[i] * lv[64 + i]; s23 += lv[128 + i] * lv[192 + i]; }
            const float lam_init = 0.8f - 0.6f * __expf(-0.3f * (float)la);
            att::AttnArgs A{(const bf16_t*)(ws + WS_Q), (const bf16_t*)(ws + WS_K), (const bf16_t*)(ws + WS_V), (bf16_t*)(ws + WS_O), (float*)(ws + WS_STASH), a.in[I_SUBLN] + lp * 128,
                            __expf(s01) - __expf(s23) + lam_init, 1.f - lam_init};
            for (int L = vcu; L < 1024 + 32; L += G) {
                if (L < 1024) { const int bh = L >> 5, qb = L & 31, b = bh >> 3, h = bh & 7;
                    att::attn_unit((LAS char*)lds, A, b * SEQ + qb * 256, h, b * SEQ, RL + b * CTXL, SEQ / 64, SEQ / 64 + CTXL / 64, wave_s_); }
                else { const int b = (L - 1024) >> 3, h = (L - 1024) & 7;
                    att::attn_unit((LAS char*)lds, A, RL + b * CTXL, h, 0, RL + b * CTXL, 0, CTXL / 64, wave_s_); }
            }
        }
        SEAM(pb + 2);
        REP(4) if (EN(4) && IN(pb + 3)) {
            ctx_gemm_resid<false>((const bf16_t*)(ws + WS_O) + (size_t)RL * DM, (const bf16_t*)(ws + WS_WO) + (size_t)lp * 1024 * 1024, 2048, XS + (size_t)RL * DM,
                                  ((rep_ + 1 < nrep_) ? (const float*)(ws + WS_CTL + 65536) : modA + 2048) + 4 * 6144, vcu, G, wave_s_);
            pg8::Gemm g{(const bf16_t*)(ws + WS_O), (const bf16_t*)(ws + WS_WO) + (size_t)lp * 1024 * 1024, 0, 1024}; pg8::StaticOrder S; S.init(RL, 1024, G, bx);
            pg8::EpiResid E{XS, (rep_ + 1 < nrep_) ? (const float*)(ws + WS_CTL + 65536) : modA + 2048, 1.f};
            pg8::gemm_phase<pg8::EpiResid, pg8::StaticOrder, true, true>(lds, g, S, E, wave_s_);
        }
        SEAM(pb + 3);
        REP(5) if (EN(5) && IN(pb + 4)) norm_phase<false, false, false, false, true>(a, lds, G, a.in[I_NFFN] + la * DM, modA, 3072, 4096, nullptr, nullptr, RT, wave_s_);
        SEAM(pb + 4);
        REP(6) if (EN(6) && IN(pb + 5)) {
            pg8::Gemm g{H, ws + WS_WGU + (size_t)lp * 2 * FF * 1024, 0, 1024}; pg8::StaticOrder S; S.init(RT, 2 * FF, G, bx);
            pg8::EpiSwiGLU<true> E{ws + WS_ACT, FF, 1.f};
            pg8::gemm_phase<pg8::EpiSwiGLU<true>, pg8::StaticOrder, true, true, true>(lds, g, S, E, wave_s_);
        }
        SEAM(pb + 5);
        REP(7) if (EN(7) && IN(pb + 6)) {
            ctx_gemm_resid<true>(ws + WS_ACT + (size_t)RL * FF, ws + WS_WDN + (size_t)lp * 1024 * FF, FF, XS + (size_t)RL * DM,
                                 ((rep_ + 1 < nrep_) ? (const float*)(ws + WS_CTL + 65536) : modA + 5120) + 4 * 6144, vcu, G, wave_s_);
            pg8::Gemm g{ws + WS_ACT, ws + WS_WDN + (size_t)lp * 1024 * FF, 0, FF}; pg8::StaticOrder S; S.init(RL, 1024, G, bx);
            pg8::EpiResid E{XS, (rep_ + 1 < nrep_) ? (const float*)(ws + WS_CTL + 65536) : modA + 5120, 1.f};
            pg8::gemm_phase<pg8::EpiResid, pg8::StaticOrder, true, true, true>(lds, g, S, E, wave_s_);
        }
        SEAM(pb + 6);
        REP(8) if (EN(8) && IN(pb + 7)) norm_phase<false, false, false, false>(a, lds, G, a.in[I_NMIX] + ll * DM, modL, 0, 1024, nullptr, nullptr, RT, wave_s_);
        SEAM(pb + 7);
        REP(9) if (EN(9) && IN(pb + 8)) {
            pg8::Gemm g{H, (const bf16_t*)(ws + WS_WIN) + (size_t)lp * 2048 * 1024, 0, 1024}; pg8::StaticOrder S; S.init(RT, 2048, G, bx);
            pg8::EpiWin E{(bf16_t*)(ws + WS_GATE), (size_t)(WS_P - WS_GATE) / 2};
            pg8::gemm_phase<pg8::EpiWin, pg8::StaticOrder, true, true>(lds, g, S, E, wave_s_);
        }
        SEAM(pb + 8);
        REP(10) if (EN(10) && IN(pb + 9)) lru_chunk_phase<false>(a, lds, vcu, G, lp, false, wave_s_);
        SEAM(pb + 9);
        REP(18) if (EN(18) && IN(pb + 10)) lru_prefix_phase(a, G, wave_s_);
        SEAM(pb + 10);
        REP(17) if (EN(17) && IN(pb + 11)) lru_chunk_phase<true>(a, lds, vcu, G, lp, lp == 1, wave_s_);
        SEAM(pb + 11);
        REP(11) if (EN(11) && IN(pb + 12)) {
            if (lp == 0) ctx_gemm_resid<false>((const bf16_t*)(ws + WS_Z) + (size_t)RL * DM, (const bf16_t*)(ws + WS_WOUT) + (size_t)lp * 1024 * 1024, 2048, XS + (size_t)RL * DM,
                                  ((rep_ + 1 < nrep_) ? (const float*)(ws + WS_CTL + 65536) : modL + 2048) + 4 * 6144, vcu, G, wave_s_);
            pg8::Gemm g{(const bf16_t*)(ws + WS_Z), (const bf16_t*)(ws + WS_WOUT) + (size_t)lp * 1024 * 1024, 0, 1024}; pg8::StaticOrder S; S.init(RL, 1024, G, bx);
            pg8::EpiResid E{XS, (rep_ + 1 < nrep_) ? (const float*)(ws + WS_CTL + 65536) : modL + 2048, 1.f};
            pg8::gemm_phase<pg8::EpiResid, pg8::StaticOrder, true, true>(lds, g, S, E, wave_s_);
        }
        SEAM(pb + 12);
        REP(12) if (EN(12) && IN(pb + 13)) norm_phase<false, false, true, false>(a, lds, G, a.in[I_NFFN] + ll * DM, modL, 3072, 4096, nullptr, a.in[I_ROUTER] + (size_t)lp * 1024 * 8, npost, wave_s_);
        SEAM(pb + 13);
        REP(13) if (EN(13) && IN(pb + 14)) moe_place_phase(a, lds, G, npost, wave_s_);
        SEAM(pb + 14);
        REP(14) if (EN(14) && IN(pb + 15)) {
            pg8::Gemm g{ws + WS_FP, ws + WS_MGU + (size_t)lp * 8 * 2 * FE * 1024, (size_t)2 * FE * 1024, 1024};
            pg8::MoeOrder S; S.init((const int*)(ws + WS_SEG), 2 * FE, G, bx);
            pg8::EpiSwiGLU<true> E{ws + WS_ACTP, FE, 1.f};
            pg8::gemm_phase<pg8::EpiSwiGLU<true>, pg8::MoeOrder, true, true, true>(lds, g, S, E, wave_s_);
        }
        SEAM(pb + 15);
        REP(15) if (EN(15) && IN(pb + 16)) {
            pg8::Gemm g{ws + WS_ACTP, ws + WS_MDN + (size_t)lp * 8 * 1024 * FE, (size_t)1024 * FE, FE};
            pg8::MoeOrder S; S.init((const int*)(ws + WS_SEG), 1024, G, bx);
            pg8::EpiBf16 E{(bf16_t*)(ws + WS_YP), 1024, 1.f};
            pg8::gemm_phase<pg8::EpiBf16, pg8::MoeOrder, true, true, true>(lds, g, S, E, wave_s_);
        }
        SEAM(pb + 16);
    }
    {
        constexpr int lp = 1;
        const int pb = 1 + 17 * lp;
        const int la = 2 * lp, ll = 2 * lp + 1, npost = (lp == 1) ? RL : RT;
        const float* modA = MOD + (size_t)la * 5 * 6144; const float* modL = MOD + (size_t)ll * 5 * 6144;
        REP(1) if (EN(1) && IN(pb + 0)) {
            if (lp == 0) norm_phase<true, false, false, false>(a, lds, G, a.in[I_NMIX] + la * DM, modA, 0, 1024, nullptr, nullptr, RT, wave_s_);
            else norm_phase<false, true, false, false>(a, lds, G, a.in[I_NMIX] + la * DM, modA, 0, 1024, MOD + (size_t)(la - 1) * 5 * 6144 + 5120, nullptr, RT, wave_s_);
        }
        SEAM(pb + 0);
        REP(2) if (EN(2) && IN(pb + 1)) {
            pg8::Gemm g{H, (const bf16_t*)(ws + WS_WQKV) + (size_t)lp * 3072 * 1024, 0, 1024}; pg8::StaticOrder S; S.init(RT, 3072, G, bx);
            pg8::EpiQKV E{(bf16_t*)(ws + WS_Q), (size_t)(WS_K - WS_Q) / 2, (const float*)(ws + WS_ROPE)};
            pg8::gemm_phase<pg8::EpiQKV, pg8::StaticOrder, true, true>(lds, g, S, E, wave_s_);
        }
        SEAM(pb + 1);
        REP(3) if (EN(3) && IN(pb + 2)) {
            const float* lv = a.in[I_LAM] + lp * 256;
            float s01 = 0.f, s23 = 0.f;
            for (int i = 0; i < 64; ++i) { s01 += lv[i] * lv[64 + i]; s23 += lv[128 + i] * lv[192 + i]; }
            const float lam_init = 0.8f - 0.6f * __expf(-0.3f * (float)la);
            att::AttnArgs A{(const bf16_t*)(ws + WS_Q), (const bf16_t*)(ws + WS_K), (const bf16_t*)(ws + WS_V), (bf16_t*)(ws + WS_O), (float*)(ws + WS_STASH), a.in[I_SUBLN] + lp * 128,
                            __expf(s01) - __expf(s23) + lam_init, 1.f - lam_init};
            for (int L = vcu; L < 1024 + 32; L += G) {
                if (L < 1024) { const int bh = L >> 5, qb = L & 31, b = bh >> 3, h = bh & 7;
                    att::attn_unit((LAS char*)lds, A, b * SEQ + qb * 256, h, b * SEQ, RL + b * CTXL, SEQ / 64, SEQ / 64 + CTXL / 64, wave_s_); }
                else { const int b = (L - 1024) >> 3, h = (L - 1024) & 7;
                    att::attn_unit((LAS char*)lds, A, RL + b * CTXL, h, 0, RL + b * CTXL, 0, CTXL / 64, wave_s_); }
            }
        }
        SEAM(pb + 2);
        REP(4) if (EN(4) && IN(pb + 3)) {
            ctx_gemm_resid<false>((const bf16_t*)(ws + WS_O) + (size_t)RL * DM, (const bf16_t*)(ws + WS_WO) + (size_t)lp * 1024 * 1024, 2048, XS + (size_t)RL * DM,
                                  ((rep_ + 1 < nrep_) ? (const float*)(ws + WS_CTL + 65536) : modA + 2048) + 4 * 6144, vcu, G, wave_s_);
            pg8::Gemm g{(const bf16_t*)(ws + WS_O), (const bf16_t*)(ws + WS_WO) + (size_t)lp * 1024 * 1024, 0, 1024}; pg8::StaticOrder S; S.init(RL, 1024, G, bx);
            pg8::EpiResid E{XS, (rep_ + 1 < nrep_) ? (const float*)(ws + WS_CTL + 65536) : modA + 2048, 1.f};
            pg8::gemm_phase<pg8::EpiResid, pg8::StaticOrder, true, true>(lds, g, S, E, wave_s_);
        }
        SEAM(pb + 3);
        REP(5) if (EN(5) && IN(pb + 4)) norm_phase<false, false, false, false, true>(a, lds, G, a.in[I_NFFN] + la * DM, modA, 3072, 4096, nullptr, nullptr, RT, wave_s_);
        SEAM(pb + 4);
        REP(6) if (EN(6) && IN(pb + 5)) {
            pg8::Gemm g{H, ws + WS_WGU + (size_t)lp * 2 * FF * 1024, 0, 1024}; pg8::StaticOrder S; S.init(RT, 2 * FF, G, bx);
            pg8::EpiSwiGLU<true> E{ws + WS_ACT, FF, 1.f};
            pg8::gemm_phase<pg8::EpiSwiGLU<true>, pg8::StaticOrder, true, true, true>(lds, g, S, E, wave_s_);
        }
        SEAM(pb + 5);
        REP(7) if (EN(7) && IN(pb + 6)) {
            ctx_gemm_resid<true>(ws + WS_ACT + (size_t)RL * FF, ws + WS_WDN + (size_t)lp * 1024 * FF, FF, XS + (size_t)RL * DM,
                                 ((rep_ + 1 < nrep_) ? (const float*)(ws + WS_CTL + 65536) : modA + 5120) + 4 * 6144, vcu, G, wave_s_);
            pg8::Gemm g{ws + WS_ACT, ws + WS_WDN + (size_t)lp * 1024 * FF, 0, FF}; pg8::StaticOrder S; S.init(RL, 1024, G, bx);
            pg8::EpiResid E{XS, (rep_ + 1 < nrep_) ? (const float*)(ws + WS_CTL + 65536) : modA + 5120, 1.f};
            pg8::gemm_phase<pg8::EpiResid, pg8::StaticOrder, true, true, true>(lds, g, S, E, wave_s_);
        }
        SEAM(pb + 6);
        REP(8) if (EN(8) && IN(pb + 7)) norm_phase<false, false, false, false>(a, lds, G, a.in[I_NMIX] + ll * DM, modL, 0, 1024, nullptr, nullptr, RT, wave_s_);
        SEAM(pb + 7);
        REP(9) if (EN(9) && IN(pb + 8)) {
            pg8::Gemm g{H, (const bf16_t*)(ws + WS_WIN) + (size_t)lp * 2048 * 1024, 0, 1024}; pg8::StaticOrder S; S.init(RT, 2048, G, bx);
            pg8::EpiWin E{(bf16_t*)(ws + WS_GATE), (size_t)(WS_P - WS_GATE) / 2};
            pg8::gemm_phase<pg8::EpiWin, pg8::StaticOrder, true, true>(lds, g, S, E, wave_s_);
        }
        SEAM(pb + 8);
        REP(10) if (EN(10) && IN(pb + 9)) lru_chunk_phase<false>(a, lds, vcu, G, lp, false, wave_s_);
        SEAM(pb + 9);
        REP(18) if (EN(18) && IN(pb + 10)) lru_prefix_phase(a, G, wave_s_);
        SEAM(pb + 10);
        REP(17) if (EN(17) && IN(pb + 11)) lru_chunk_phase<true>(a, lds, vcu, G, lp, lp == 1, wave_s_);
        SEAM(pb + 11);
        REP(11) if (EN(11) && IN(pb + 12)) {
            if (lp == 0) ctx_gemm_resid<false>((const bf16_t*)(ws + WS_Z) + (size_t)RL * DM, (const bf16_t*)(ws + WS_WOUT) + (size_t)lp * 1024 * 1024, 2048, XS + (size_t)RL * DM,
                                  ((rep_ + 1 < nrep_) ? (const float*)(ws + WS_CTL + 65536) : modL + 2048) + 4 * 6144, vcu, G, wave_s_);
            pg8::Gemm g{(const bf16_t*)(ws + WS_Z), (const bf16_t*)(ws + WS_WOUT) + (size_t)lp * 1024 * 1024, 0, 1024}; pg8::StaticOrder S; S.init(RL, 1024, G, bx);
            pg8::EpiResid E{XS, (rep_ + 1 < nrep_) ? (const float*)(ws + WS_CTL + 65536) : modL + 2048, 1.f};
            pg8::gemm_phase<pg8::EpiResid, pg8::StaticOrder, true, true>(lds, g, S, E, wave_s_);
        }
        SEAM(pb + 12);
        REP(12) if (EN(12) && IN(pb + 13)) norm_phase<false, false, true, false>(a, lds, G, a.in[I_NFFN] + ll * DM, modL, 3072, 4096, nullptr, a.in[I_ROUTER] + (size_t)lp * 1024 * 8, npost, wave_s_);
        SEAM(pb + 13);
        REP(13) if (EN(13) && IN(pb + 14)) moe_place_phase(a, lds, G, npost, wave_s_);
        SEAM(pb + 14);
        REP(14) if (EN(14) && IN(pb + 15)) {
            pg8::Gemm g{ws + WS_FP, ws + WS_MGU + (size_t)lp * 8 * 2 * FE * 1024, (size_t)2 * FE * 1024, 1024};
            pg8::MoeOrder S; S.init((const int*)(ws + WS_SEG), 2 * FE, G, bx);
            pg8::EpiSwiGLU<true> E{ws + WS_ACTP, FE, 1.f};
            pg8::gemm_phase<pg8::EpiSwiGLU<true>, pg8::MoeOrder, true, true, true>(lds, g, S, E, wave_s_);
        }
        SEAM(pb + 15);
        REP(15) if (EN(15) && IN(pb + 16)) {
            pg8::Gemm g{ws + WS_ACTP, ws + WS_MDN + (size_t)lp * 8 * 1024 * FE, (size_t)1024 * FE, FE};
            pg8::MoeOrder S; S.init((const int*)(ws + WS_SEG), 1024, G, bx);
            pg8::EpiBf16 E{(bf16_t*)(ws + WS_YP), 1024, 1.f};
            pg8::gemm_phase<pg8::EpiBf16, pg8::MoeOrder, true, true, true>(lds, g, S, E, wave_s_);
        }
        SEAM(pb + 16);
    }
    REP(16) if (EN(16) && IN(35)) norm_phase<false, true, false, true>(a, lds, G, a.in[I_FNORM], nullptr, 0, 0, MOD + (size_t)3 * 5 * 6144 + 5120, nullptr, RL, wave_s_);
#undef IN
#undef SEAM
}

extern "C" void kernel_launch(void* const* d_in, const int* in_sizes, int n_in, void* d_out, int out_size, void* d_ws, size_t ws_size, hipStream_t stream) {
    static int grid = 0;
    if (grid == 0) {
        if (n_in != 25 || in_sizes[0] != RL * DM || out_size != RL * DM || ws_size < WS_END) {
            fprintf(stderr, "kernel_launch: shape mismatch: n_in %d in0 %d out %d ws %zu (need %zu)\n", n_in, n_in > 0 ? in_sizes[0] : -1, out_size, ws_size, (size_t)WS_END); grid = -1; return; }
        int dev = 0, cus = 0, per_cu = 0;
        if (hipGetDevice(&dev) != hipSuccess || hipDeviceGetAttribute(&cus, hipDeviceAttributeMultiprocessorCount, dev) != hipSuccess) { grid = -1; return; }
        if (hipFuncSetAttribute((const void*)dit_fwd, hipFuncAttributeMaxDynamicSharedMemorySize, LDS_BYTES) != hipSuccess) { fprintf(stderr, "kernel_launch: hipFuncSetAttribute failed\n"); grid = -1; return; }
        if (hipOccupancyMaxActiveBlocksPerMultiprocessor(&per_cu, (const void*)dit_fwd, 512, LDS_BYTES) != hipSuccess || per_cu < 1)
            fprintf(stderr, "kernel_launch: note: occupancy query reports %d workgroups per CU\n", per_cu);
        (void)hipGetLastError();
        grid = cus;
        if (grid > 1024) grid = 1024;
    }
    if (grid < 0) return;
    if (hipMemsetAsync((char*)d_ws + WS_CTL, 0, CTL_ZERO_BYTES, stream) != hipSuccess) { fprintf(stderr, "kernel_launch: memset failed\n"); return; }
    KArgs a{};
    for (int i = 0; i < 25; ++i) a.in[i] = (const float*)d_in[i];
    a.out = (float*)d_out; a.ws = (unsigned char*)d_ws;
#if MK_SPLIT
    for (int p = 0; p < NPHASE; ++p) { a.ph_lo = p; a.ph_hi = p + 1; hipLaunchKernelGGL(dit_fwd, dim3(grid), dim3(512), LDS_BYTES, stream, a); }
#else
    a.ph_lo = 0; a.ph_hi = NPHASE; hipLaunchKernelGGL(dit_fwd, dim3(grid), dim3(512), LDS_BYTES, stream, a);
#endif
    const hipError_t le = hipPeekAtLastError();
    if (le != hipSuccess) fprintf(stderr, "kernel_launch: launch failed: %s\n", hipGetErrorName(le));
}
```
